# Optimizing an MI355X kernel written in HIP

```python
import math
import jax
import jax.numpy as jnp
from jax import lax
import numpy as np

D_MODEL = 1024
BATCH = 16
SEQ = 256
DEPTH = 4
DEC_BATCH = 4
DEC_SEQ = 4096
PAST_LEN = 256

GRID_W = 64
N_EVEN = (DEPTH + 1) // 2
N_ODD = DEPTH // 2
BLK = 128
WINDOW = 128
HD = 64
H_A = 8
KV_A = 2
G_A = H_A // KV_A
NG_B = 4
CG_B = 128
H_C = 4
HD_C = 64
H_D = 4
DK_D = 128
DV_D = 128
CHUNK = 128
D_FF = 2816
N_MOD = 9
ROPE_BASE = 10000.0
N_FREQ = HD // 4
EPS = 1e-6

W_QA = H_A * HD
W_KA = KV_A * HD
W_B = NG_B * CG_B
W_IN_EVEN = W_QA + 2 * W_KA + W_B
W_MIX_EVEN = W_QA + W_B
W_QC = H_C * 2 * HD_C
W_VC = H_C * 2 * HD_C
W_QD = H_D * DK_D
W_VD = H_D * DV_D
N_GATE_D = 4 * H_D
W_IN_ODD = 2 * W_QC + W_VC + 2 * W_QD + 2 * W_VD + N_GATE_D
W_MIX_ODD = W_VC + W_VD

kernel_name = 'hybrid_diffusion_prefix_trunk_step'


def rms_norm(x, g):
    xf = x.astype(jnp.float32)
    y = xf * lax.rsqrt(jnp.mean(xf * xf, axis=-1, keepdims=True) + EPS)
    return (y * g.astype(jnp.float32)).astype(x.dtype)


def swiglu(h, w_i, w_o):
    gate, up = jnp.split(h @ w_i, 2, axis=-1)
    return (jax.nn.silu(gate) * up) @ w_o


def ffn_half(x, mod, j, g, w_i, w_o):
    h = rms_norm(x, g) * (1 + mod[..., 3 * j + 1, :]) + mod[..., 3 * j, :]
    return x + 0.5 * mod[..., 3 * j + 2, :] * swiglu(h, w_i, w_o)


def grid_rope_tables(n_tokens):
    rows = n_tokens // GRID_W
    row = jnp.repeat(jnp.arange(rows), GRID_W).astype(jnp.float32)
    col = jnp.tile(jnp.arange(GRID_W), rows).astype(jnp.float32)
    inv = ROPE_BASE ** (-jnp.arange(N_FREQ, dtype=jnp.float32) / N_FREQ)
    ang = jnp.stack([row[:, None] * inv, col[:, None] * inv], axis=1)
    return jnp.cos(ang), jnp.sin(ang)


def rope2d(x, rope):
    cos, sin = rope
    xs = x.astype(jnp.float32).reshape(x.shape[:-1] + (2, 2, N_FREQ))
    x1, x2 = xs[..., 0, :], xs[..., 1, :]
    shp = (cos.shape[0],) + (1,) * (x1.ndim - 4) + (2, N_FREQ)
    c, s = cos.reshape(shp), sin.reshape(shp)
    out = jnp.stack([x1 * c - x2 * s, x1 * s + x2 * c], axis=-2)
    return out.reshape(x.shape).astype(x.dtype)


def to_blocks(a, size):
    b, s = a.shape[:2]
    return jnp.moveaxis(a.reshape((b, s // size, size) + a.shape[2:]), 1, 0)


def from_blocks(a):
    a = jnp.moveaxis(a, 0, 1)
    return a.reshape((a.shape[0], a.shape[1] * a.shape[2]) + a.shape[3:])


def sink_softmax(s, sink):
    sk = jnp.broadcast_to(sink.astype(jnp.float32), s.shape[:-1] + (1,))
    return jax.nn.softmax(jnp.concatenate([s, sk], axis=-1), axis=-1)[..., :-1]


def context_attn_sink(q, k, v, sink):
    b, s = q.shape[:2]
    qg = q.reshape(b, s, KV_A, G_A, HD)
    sink_b = sink.reshape(KV_A, G_A, 1, 1)

    def block(qb):
        sc = jnp.einsum('bqkgd,bckd->bkgqc', qb, k).astype(jnp.float32) * HD ** -0.5
        p = sink_softmax(sc, sink_b)
        return jnp.einsum('bkgqc,bckd->bqkgd', p.astype(v.dtype), v)

    out = from_blocks(lax.map(block, to_blocks(qg, BLK)))
    return out.reshape(b, s, H_A, HD)


def window_attn_sink(q, k, v, kc, vc, sink):
    b, s = q.shape[:2]
    nb = s // BLK
    qb = q.reshape(b, nb, BLK, KV_A, G_A, HD)
    pad = ((0, 0), (BLK, BLK), (0, 0), (0, 0))
    kp = jnp.pad(k, pad).reshape(b, nb + 2, BLK, KV_A, HD)
    vp = jnp.pad(v, pad).reshape(b, nb + 2, BLK, KV_A, HD)
    kw = jnp.concatenate([kp[:, :-2], kp[:, 1:-1], kp[:, 2:]], axis=2)
    vw = jnp.concatenate([vp[:, :-2], vp[:, 1:-1], vp[:, 2:]], axis=2)
    scale = HD ** -0.5
    s_loc = jnp.einsum('bnqkgd,bnjkd->bnkgqj', qb, kw).astype(jnp.float32) * scale
    s_ctx = jnp.einsum('bnqkgd,bckd->bnkgqc', qb, kc).astype(jnp.float32) * scale
    blk_i = jnp.arange(nb)[:, None, None]
    qpos = blk_i * BLK + jnp.arange(BLK)[None, :, None]
    kpos = (blk_i - 1) * BLK + jnp.arange(3 * BLK)[None, None, :]
    valid = (jnp.abs(qpos - kpos) <= WINDOW) & (kpos >= 0) & (kpos < s)
    s_loc = jnp.where(valid[None, :, None, None], s_loc, -jnp.inf)
    p = sink_softmax(jnp.concatenate([s_loc, s_ctx], axis=-1), sink.reshape(KV_A, G_A, 1, 1)).astype(v.dtype)
    out = (jnp.einsum('bnkgqj,bnjkd->bnqkgd', p[..., :3 * BLK], vw)
           + jnp.einsum('bnkgqc,bckd->bnqkgd', p[..., 3 * BLK:], vc))
    return out.reshape(b, s, H_A, HD)


def fourier_mix(u):
    f = jnp.fft.fft2(u.astype(jnp.float32), axes=(1, 3), norm='ortho')
    return jnp.real(f).astype(u.dtype)


def mixer_even(h, w_in, w_out, qn, kn, sink, rope, ctx_k, ctx_v):
    b, s, _ = h.shape
    p = h @ w_in
    q = rms_norm(p[..., :W_QA].reshape(b, s, H_A, HD), qn)
    k = rms_norm(p[..., W_QA:W_QA + W_KA].reshape(b, s, KV_A, HD), kn)
    v = p[..., W_QA + W_KA:W_QA + 2 * W_KA].reshape(b, s, KV_A, HD)
    u = p[..., W_QA + 2 * W_KA:].reshape(b, s, NG_B, CG_B)
    if ctx_k is None:
        a = context_attn_sink(q, k, v, sink)
        new = (k, v)
    else:
        a = window_attn_sink(rope2d(q, rope), rope2d(k, rope), v, ctx_k, ctx_v, sink)
        new = None
    f = fourier_mix(u)
    out = jnp.concatenate([a.reshape(b, s, W_QA), f.reshape(b, s, W_B)], axis=-1) @ w_out
    return out, new


def diff_attention(q, k, v, lam_vecs, lam_init, subln_g):
    lv = lam_vecs.astype(jnp.float32)
    lam = jnp.exp(jnp.sum(lv[0] * lv[1])) - jnp.exp(jnp.sum(lv[2] * lv[3])) + lam_init

    def block(qb):
        sc = jnp.einsum('bqhid,bkhid->bihqk', qb, k).astype(jnp.float32) * HD_C ** -0.5
        pr = jax.nn.softmax(sc, axis=-1)
        a = pr[:, 0] - lam * pr[:, 1]
        return jnp.einsum('bhqk,bkhe->bqhe', a.astype(v.dtype), v)

    o = from_blocks(lax.map(block, to_blocks(q, BLK)))
    return rms_norm(o, subln_g) * (1.0 - lam_init)


def mlstm_chunked(q, k, v, ig, fg, c0, n0, m0):
    f32 = jnp.float32
    logf = jax.nn.log_sigmoid(fg.astype(f32))
    tril = jnp.tril(jnp.ones((CHUNK, CHUNK), dtype=bool))

    def step(carry, xs):
        c, n, m = carry
        qc, kc, vc, ic, fc = xs
        bcum = jnp.cumsum(fc, axis=1)
        dlog = bcum[:, :, None, :] - bcum[:, None, :, :] + ic[:, None, :, :]
        dlog = jnp.where(tril[None, :, :, None], dlog, -jnp.inf)
        g = bcum + m[:, None, :]
        mt = jnp.maximum(g, jnp.max(dlog, axis=2))
        w = jnp.exp(dlog - mt[:, :, None, :])
        winter = jnp.exp(g - mt)
        sc = jnp.einsum('bthd,bshd->btsh', qc, kc) * w
        num = (jnp.einsum('btsh,bshv->bthv', sc, vc)
               + winter[..., None] * jnp.einsum('bthd,bhdv->bthv', qc, c))
        den = jnp.sum(sc, axis=2) + winter * jnp.einsum('bthd,bhd->bth', qc, n)
        hc = num / jnp.maximum(jnp.abs(den), jnp.exp(-mt))[..., None]
        b_end = bcum[:, -1]
        wlog = b_end[:, None, :] - bcum + ic
        m_new = jnp.maximum(b_end + m, jnp.max(wlog, axis=1))
        ws = jnp.exp(wlog - m_new[:, None, :])
        decay = jnp.exp(b_end + m - m_new)
        c_new = decay[..., None, None] * c + jnp.einsum('bsh,bshd,bshv->bhdv', ws, kc, vc)
        n_new = decay[..., None] * n + jnp.einsum('bsh,bshd->bhd', ws, kc)
        return (c_new, n_new, m_new), hc

    xs = tuple(to_blocks(a.astype(f32), CHUNK) for a in (q, k, v, ig, logf))
    carry, hs = lax.scan(step, (c0.astype(f32), n0.astype(f32), m0.astype(f32)), xs)
    return from_blocks(hs), carry


def mixer_odd(h, w_in, b_gate, w_out, qn, kn, lam_vecs, subln_g, outnorm_g, lam_init, rope, ctx):
    b, s, _ = h.shape
    f32 = jnp.float32
    p = h @ w_in
    sizes = (W_QC, W_QC, W_VC, W_QD, W_QD, W_VD, W_VD)
    bounds = []
    acc = 0
    for sz in sizes:
        acc += sz
        bounds.append(acc)
    qc, kc, vc, qd, kd, vd, od, gates = jnp.split(p, bounds, axis=-1)
    qc = rms_norm(qc.reshape(b, s, H_C, 2, HD_C), qn)
    kc = rms_norm(kc.reshape(b, s, H_C, 2, HD_C), kn)
    vc = vc.reshape(b, s, H_C, 2 * HD_C)
    qd = qd.reshape(b, s, H_D, DK_D)
    kd = kd.reshape(b, s, H_D, DK_D) * DK_D ** -0.5
    vd = vd.reshape(b, s, H_D, DV_D)
    gates = (gates + b_gate).astype(f32).reshape(b, s, 2, 2, H_D)
    if ctx is None:
        keys, vals = kc, vc
        c0 = jnp.zeros((b, 2, H_D, DK_D, DV_D), f32)
        n0 = jnp.zeros((b, 2, H_D, DK_D), f32)
        m0 = jnp.zeros((b, 2, H_D), f32)
    else:
        ck, cv, c0, n0, m0 = ctx
        qc = rope2d(qc, rope)
        keys = jnp.concatenate([rope2d(kc, rope), ck], axis=1)
        vals = jnp.concatenate([vc, cv], axis=1)
    a = diff_attention(qc, keys, vals, lam_vecs, lam_init, subln_g)
    h_f, (cf, nf, mf) = mlstm_chunked(qd, kd, vd, gates[:, :, 0, 0], gates[:, :, 0, 1],
                                      c0[:, 0], n0[:, 0], m0[:, 0])
    h_b, (cb, nbk, mb) = mlstm_chunked(jnp.flip(qd, 1), jnp.flip(kd, 1), jnp.flip(vd, 1),
                                       jnp.flip(gates[:, :, 1, 0], 1), jnp.flip(gates[:, :, 1, 1], 1),
                                       c0[:, 1], n0[:, 1], m0[:, 1])
    hm = rms_norm(h_f + jnp.flip(h_b, 1), outnorm_g).astype(h.dtype)
    hm = hm * jax.nn.sigmoid(od.reshape(b, s, H_D, DV_D))
    out = jnp.concatenate([a.reshape(b, s, W_VC), hm.reshape(b, s, W_VD)], axis=-1) @ w_out
    if ctx is None:
        new = (kc, vc, jnp.stack([cf, cb], axis=1), jnp.stack([nf, nbk], axis=1), jnp.stack([mf, mb], axis=1))
    else:
        new = None
    return out, new


def setup_inputs(seed: int = 0) -> dict:
    key = jax.random.key(seed)
    ks = jax.random.split(key, 32)

    def nrm(k, shape, s):
        return jax.random.normal(k, shape, jnp.float32) * s

    gate_offset = jnp.tile(jnp.repeat(jnp.array([0.0, 3.0], jnp.float32), H_D), 2)
    return {
        'x_prompt': nrm(ks[0], (BATCH, SEQ, D_MODEL), 1.0),
        'x_sample': nrm(ks[1], (DEC_BATCH, DEC_SEQ, D_MODEL), 1.0),
        'c': nrm(ks[2], (DEC_BATCH, D_MODEL), 1.0),
        'cache_k_a': nrm(ks[3], (DEC_BATCH, N_EVEN, PAST_LEN, KV_A, HD), 1.0),
        'cache_v_a': nrm(ks[4], (DEC_BATCH, N_EVEN, PAST_LEN, KV_A, HD), 1.0),
        'cache_k_c': nrm(ks[5], (DEC_BATCH, N_ODD, PAST_LEN, H_C, 2, HD_C), 1.0),
        'cache_v_c': nrm(ks[6], (DEC_BATCH, N_ODD, PAST_LEN, H_C, 2 * HD_C), 1.0),
        'state_C_d': nrm(ks[7], (DEC_BATCH, N_ODD, 2, H_D, DK_D, DV_D), 0.05),
        'state_n_d': nrm(ks[8], (DEC_BATCH, N_ODD, 2, H_D, DK_D), 0.5),
        'state_m_d': nrm(ks[9], (DEC_BATCH, N_ODD, 2, H_D), 1.0),
        'c_ctx': nrm(ks[10], (D_MODEL,), 1.0),
        'w_ada': nrm(ks[11], (DEPTH, D_MODEL, N_MOD * D_MODEL), 0.5 * D_MODEL ** -0.5),
        'b_ada': nrm(ks[12], (DEPTH, N_MOD * D_MODEL), 0.02),
        'g_norm': 1.0 + nrm(ks[13], (DEPTH, 3, D_MODEL), 0.02),
        'w_ffn_in': nrm(ks[14], (DEPTH, 2, D_MODEL, 2 * D_FF), D_MODEL ** -0.5),
        'w_ffn_out': nrm(ks[15], (DEPTH, 2, D_FF, D_MODEL), D_FF ** -0.5),
        'w_in_even': nrm(ks[16], (N_EVEN, D_MODEL, W_IN_EVEN), D_MODEL ** -0.5),
        'w_out_even': nrm(ks[17], (N_EVEN, W_MIX_EVEN, D_MODEL), W_MIX_EVEN ** -0.5),
        'qn_a': 1.0 + nrm(ks[18], (N_EVEN, HD), 0.02),
        'kn_a': 1.0 + nrm(ks[19], (N_EVEN, HD), 0.02),
        'sink_a': nrm(ks[20], (N_EVEN, H_A), 0.5),
        'w_in_odd': nrm(ks[21], (N_ODD, D_MODEL, W_IN_ODD), D_MODEL ** -0.5),
        'b_gate_odd': nrm(ks[22], (N_ODD, N_GATE_D), 0.1) + gate_offset,
        'w_out_odd': nrm(ks[23], (N_ODD, W_MIX_ODD, D_MODEL), W_MIX_ODD ** -0.5),
        'qn_c': 1.0 + nrm(ks[24], (N_ODD, HD_C), 0.02),
        'kn_c': 1.0 + nrm(ks[25], (N_ODD, HD_C), 0.02),
        'lam_c': nrm(ks[26], (N_ODD, 4, HD_C), 0.1),
        'subln_c': 1.0 + nrm(ks[27], (N_ODD, 2 * HD_C), 0.02),
        'outnorm_d': 1.0 + nrm(ks[28], (N_ODD, DV_D), 0.02),
    }


def reference(x_prompt, x_sample, c, cache_k_a, cache_v_a, cache_k_c, cache_v_c, state_C_d, state_n_d,
              state_m_d, c_ctx, w_ada, b_ada, g_norm, w_ffn_in, w_ffn_out, w_in_even, w_out_even, qn_a, kn_a,
              sink_a, w_in_odd, b_gate_odd, w_out_odd, qn_c, kn_c, lam_c, subln_c, outnorm_d):
    rope = grid_rope_tables(x_sample.shape[1])
    yp, ys = x_prompt, x_sample
    ka_l, va_l, kc_l, vc_l, cd_l, nd_l, md_l = [], [], [], [], [], [], []
    for l in range(DEPTH):
        i = l // 2
        mc = (jax.nn.silu(c_ctx) @ w_ada[l] + b_ada[l]).reshape(1, 1, N_MOD, D_MODEL)
        ms = (jax.nn.silu(c) @ w_ada[l] + b_ada[l]).reshape(c.shape[0], 1, N_MOD, D_MODEL)
        yp = ffn_half(yp, mc, 0, g_norm[l, 0], w_ffn_in[l, 0], w_ffn_out[l, 0])
        ys = ffn_half(ys, ms, 0, g_norm[l, 0], w_ffn_in[l, 0], w_ffn_out[l, 0])
        hp = rms_norm(yp, g_norm[l, 1]) * (1 + mc[..., 4, :]) + mc[..., 3, :]
        hs = rms_norm(ys, g_norm[l, 1]) * (1 + ms[..., 4, :]) + ms[..., 3, :]
        if l % 2 == 0:
            op, (ka, va) = mixer_even(hp, w_in_even[i], w_out_even[i], qn_a[i], kn_a[i], sink_a[i],
                                      None, None, None)
            os_, _ = mixer_even(hs, w_in_even[i], w_out_even[i], qn_a[i], kn_a[i], sink_a[i],
                                rope, cache_k_a[:, i], cache_v_a[:, i])
            ka_l.append(ka)
            va_l.append(va)
        else:
            lam_init = 0.8 - 0.6 * math.exp(-0.3 * l)
            op, (kc, vc, cd, nd, md) = mixer_odd(hp, w_in_odd[i], b_gate_odd[i], w_out_odd[i], qn_c[i], kn_c[i],
                                                 lam_c[i], subln_c[i], outnorm_d[i], lam_init, None, None)
            os_, _ = mixer_odd(hs, w_in_odd[i], b_gate_odd[i], w_out_odd[i], qn_c[i], kn_c[i],
                               lam_c[i], subln_c[i], outnorm_d[i], lam_init, rope,
                               (cache_k_c[:, i], cache_v_c[:, i], state_C_d[:, i], state_n_d[:, i],
                                state_m_d[:, i]))
            kc_l.append(kc)
            vc_l.append(vc)
            cd_l.append(cd)
            nd_l.append(nd)
            md_l.append(md)
        yp = yp + mc[..., 5, :] * op
        ys = ys + ms[..., 5, :] * os_
        yp = ffn_half(yp, mc, 2, g_norm[l, 2], w_ffn_in[l, 1], w_ffn_out[l, 1])
        ys = ffn_half(ys, ms, 2, g_norm[l, 2], w_ffn_in[l, 1], w_ffn_out[l, 1])
    new_k_a = jnp.stack(ka_l, axis=1)
    new_v_a = jnp.stack(va_l, axis=1)
    new_k_c = jnp.stack(kc_l, axis=1)
    new_v_c = jnp.stack(vc_l, axis=1)
    new_C_d = jnp.stack(cd_l, axis=1)
    new_n_d = jnp.stack(nd_l, axis=1)
    new_m_d = jnp.stack(md_l, axis=1)
    return (yp, ys, new_k_a, new_v_a, new_k_c, new_v_c, new_C_d, new_n_d, new_m_d)
```

```cpp
#include <hip/hip_runtime.h>
#include <hip/hip_cooperative_groups.h>
#include <cstdio>
#include <cstdint>
namespace cg = cooperative_groups;
__device__ __forceinline__ int tid_opaque() { int t = threadIdx.x; asm volatile("" : "+v"(t)); return t; }
__device__ __forceinline__ int bid_opaque() { int b = blockIdx.x; asm volatile("" : "+s"(b)); return b; }
namespace pg8 {
#define PG8_LAS __attribute__((address_space(3)))
typedef unsigned short bf16_t;
typedef short bf16x8 __attribute__((ext_vector_type(8)));
typedef float f32x4 __attribute__((ext_vector_type(4)));
typedef unsigned u32x4 __attribute__((ext_vector_type(4)));
constexpr int BM = 256, BK = 64, HALF = 128, HTB = HALF * BK * 2  , STAGE_BYTES = 8 * HTB, NXCD = 8, WGM = 4;

__host__ __device__ __forceinline__ int lds_byte(int r, int c) { const int st = (r >> 4) * 2 + (c >> 5), rr = r & 15, cc = c & 31, ob = rr * 64 + cc * 2; return st * 1024 + (ob ^ (((ob >> 9) & 1) << 5)); }
__host__ __device__ __forceinline__ void stage_rc(int b, int& R, int& C) { const int st = b / 1024, sb = b % 1024, swz = sb ^ (((sb >> 9) & 1) << 5); R = (st >> 1) * 16 + swz / 64; C = (st & 1) * 32 + (swz % 64) / 2; }
__host__ __device__ __forceinline__ int perm32(int rho) { const int n = rho >> 4, i = rho & 15; return 8 * (i >> 2) + 4 * n + (i & 3); }

struct Unit { int pm, pn, qm; };
struct Gemm { const bf16_t* A; const bf16_t* Bt; int M, N, K, ld; };

struct StaticOrder {
    int nM, nN, nwg, G, c;
    __host__ __device__ void init(int M, int N, int G_, int c_) { nM = M / BM; nN = N / BM; nwg = nM * nN; G = G_; c = c_; }
    __host__ __device__ bool next(int i, Unit& u) const {
        const long L = (long)i * G + c; if (L >= nwg) return false;
        int wgid = (int)L; { const int q = nwg / NXCD, r = nwg % NXCD, xcd = wgid % NXCD, off = wgid / NXCD; wgid = (xcd < r ? xcd * (q + 1) : r * (q + 1) + (xcd - r) * q) + off; }
        const int nig = WGM * nN, gid = wgid / nig, fm = gid * WGM, gsz = (nM - fm) < WGM ? (nM - fm) : WGM;
        u.pm = fm + ((wgid % nig) % gsz); u.pn = (wgid % nig) / gsz; u.qm = 15; return true;
    }
    __device__ __forceinline__ void a_ready(const Unit&) const {}
    __device__ __forceinline__ void done(const Unit&) const {}
};

__device__ __forceinline__ unsigned cvt_pk_bf16(float lo, float hi) { unsigned r; asm volatile("v_cvt_pk_bf16_f32 %0, %1, %2" : "=v"(r) : "v"(lo), "v"(hi)); return r; }
typedef float f32x2 __attribute__((ext_vector_type(2)));
template <class Epi, class Sched, bool ALIGN_EPI = false, bool SP2 = false>
__device__ __forceinline__ void gemm_phase(PG8_LAS unsigned char* lds, const Gemm g, const Sched& S, const Epi& E) {
    const int tid = tid_opaque(), wid = __builtin_amdgcn_readfirstlane(tid >> 6), lane = tid & 63, wr = wid >> 2, wc = wid & 3, fr = lane & 15, fq = lane >> 4;
    const int K = g.K, nt = K / BK, LD = g.ld ? g.ld : g.K;
    unsigned voffA[2], voffB[2];
#pragma unroll
    for (int i = 0; i < 2; ++i) { int R, C; stage_rc(tid * 16 + i * 8192, R, C); const int Rb = Epi::PERM ? ((R & ~31) + perm32(R & 31)) : R;
        voffA[i] = (unsigned)(R * LD + C) * 2u; voffB[i] = (unsigned)(Rb * LD + C) * 2u; }
    const size_t kstep = (size_t)(BK * 2);
    const size_t hstep = (size_t)HALF * LD * 2;
    const size_t tstep = 2 * hstep;
    const unsigned ldsw = (unsigned)wid * 1024u;
    const int aoff = lds_byte(wr * 64 + fr, fq * 8), boff = lds_byte(wc * 32 + fr, fq * 8);
#define PG8_SA(b, h) (((b) * 2 + (h)) * HTB)
#define PG8_SB(b, h) ((4 + (b) * 2 + (h)) * HTB)
#define PG8_STAGE(bufoff, gbase, voff) do { _Pragma("unroll") for (int _i = 0; _i < 2; ++_i) \
        __builtin_amdgcn_global_load_lds((const unsigned*)((const char*)(gbase) + (voff)[_i]), (PG8_LAS unsigned*)(lds + (bufoff) + ldsw + _i * 8192), 16, 0, 0); } while (0)
#define PG8_LDA(dst, b, h) do { _Pragma("unroll") for (int m = 0; m < 4; ++m) _Pragma("unroll") for (int k = 0; k < 2; ++k) dst[m][k] = *(const PG8_LAS bf16x8*)(lds + PG8_SA(b, h) + aoff + m * 2048 + k * 1024); } while (0)
#define PG8_LDB(dst, b, h) do { _Pragma("unroll") for (int n = 0; n < 2; ++n) _Pragma("unroll") for (int k = 0; k < 2; ++k) dst[n][k] = *(const PG8_LAS bf16x8*)(lds + PG8_SB(b, h) + boff + n * 2048 + k * 1024); } while (0)
#define PG8_MMA(ai, bj, At, Bt) do { if (!(cur.qm & (1 << (2 * (ai) + (bj))))) break; __builtin_amdgcn_s_setprio(1); _Pragma("unroll") for (int m = 0; m < 4; ++m) _Pragma("unroll") for (int n = 0; n < 2; ++n) _Pragma("unroll") for (int k = 0; k < 2; ++k) \
        acc[ai][bj][m][n] = __builtin_amdgcn_mfma_f32_16x16x32_bf16(Bt[n][k], At[m][k], acc[ai][bj][m][n], 0, 0, 0); __builtin_amdgcn_s_setprio(0); } while (0)
#define PG8_WAIT_V(n) asm volatile("s_waitcnt vmcnt(" #n ")" ::: "memory")
#define PG8_WAIT_L(n) asm volatile("s_waitcnt lgkmcnt(" #n ")" ::: "memory")
#define PG8_BAR __builtin_amdgcn_s_barrier()
#define PG8_SCHED __builtin_amdgcn_sched_barrier(0)
    Unit cur, nxt; int ui = 0;
    if (!S.next(0, cur)) return;
    f32x4 acc[2][2][4][2];
#pragma unroll
    for (int a = 0; a < 2; ++a)
#pragma unroll
        for (int b = 0; b < 2; ++b)
#pragma unroll
            for (int m = 0; m < 4; ++m)
#pragma unroll
                for (int n = 0; n < 2; ++n) acc[a][b][m][n] = (f32x4){0.f, 0.f, 0.f, 0.f};
    bf16x8 At[4][2], B0[2][2], B1[2][2];
    const char* cA = (const char*)g.A + (size_t)cur.pm * tstep; const char* cB = (const char*)g.Bt + (size_t)cur.pn * tstep;
    S.a_ready(cur);
    if constexpr (SP2) {
        PG8_STAGE(PG8_SB(0, 0), cB, voffB); PG8_STAGE(PG8_SB(0, 1), cB + hstep, voffB); PG8_STAGE(PG8_SA(0, 0), cA, voffA); PG8_STAGE(PG8_SA(0, 1), cA + hstep, voffA);
        if (wr == 1) PG8_BAR;
        PG8_WAIT_V(2); PG8_BAR;
        PG8_STAGE(PG8_SB(1, 0), cB + kstep, voffB); PG8_STAGE(PG8_SA(1, 0), cA + kstep, voffA); PG8_STAGE(PG8_SB(1, 1), cB + hstep + kstep, voffB);
        PG8_WAIT_V(6); PG8_BAR;
    } else {
        PG8_STAGE(PG8_SB(0, 0), cB, voffB); PG8_STAGE(PG8_SA(0, 0), cA, voffA); PG8_STAGE(PG8_SB(0, 1), cB + hstep, voffB); PG8_STAGE(PG8_SA(0, 1), cA + hstep, voffA);
        if (wr == 1) PG8_BAR;
        PG8_WAIT_V(4); PG8_BAR;
        PG8_STAGE(PG8_SB(1, 0), cB + kstep, voffB); PG8_STAGE(PG8_SA(1, 0), cA + kstep, voffA); PG8_STAGE(PG8_SB(1, 1), cB + hstep + kstep, voffB);
        PG8_WAIT_V(6); PG8_BAR;
    }
    for (;;) {
        const bool has_next = S.next(ui + 1, nxt);
        const char* nA = has_next ? (const char*)g.A + (size_t)nxt.pm * tstep : cA; const char* nB = has_next ? (const char*)g.Bt + (size_t)nxt.pn * tstep : cB;
        for (int t = 0; t < nt; t += 2) {
            const bool last = (t == nt - 2);
            const char* a1 = cA + (size_t)(t + 1) * kstep;
            const char* a2 = last ? nA : cA + (size_t)(t + 2) * kstep; const char* b2 = last ? nB : cB + (size_t)(t + 2) * kstep;
            const char* a3 = a2 + kstep; const char* b3 = b2 + kstep;
            if (last && has_next) S.a_ready(nxt);
            if constexpr (SP2) {
            PG8_LDB(B0, 0, 0); PG8_LDB(B1, 0, 1); PG8_SCHED; PG8_LDA(At, 0, 0); PG8_STAGE(PG8_SA(1, 1), a1 + hstep, voffA);
            PG8_WAIT_V(8); PG8_WAIT_L(0); PG8_BAR; PG8_MMA(0, 0, At, B0); PG8_MMA(0, 1, At, B1); PG8_BAR; PG8_SCHED;
            PG8_LDA(At, 0, 1); PG8_STAGE(PG8_SB(0, 0), b2, voffB); PG8_STAGE(PG8_SB(0, 1), b2 + hstep, voffB); PG8_STAGE(PG8_SA(0, 0), a2, voffA);
            PG8_WAIT_V(8); PG8_WAIT_L(0); PG8_BAR; PG8_MMA(1, 0, At, B0); PG8_MMA(1, 1, At, B1); PG8_BAR; PG8_SCHED;
            PG8_LDB(B0, 1, 0); PG8_LDB(B1, 1, 1); PG8_SCHED; PG8_LDA(At, 1, 0); PG8_STAGE(PG8_SA(0, 1), a2 + hstep, voffA);
            PG8_WAIT_V(8); PG8_WAIT_L(0); PG8_BAR; PG8_MMA(0, 0, At, B0); PG8_MMA(0, 1, At, B1); PG8_BAR; PG8_SCHED;
            PG8_LDA(At, 1, 1); PG8_STAGE(PG8_SB(1, 0), b3, voffB); PG8_STAGE(PG8_SB(1, 1), b3 + hstep, voffB); PG8_STAGE(PG8_SA(1, 0), a3, voffA);
            PG8_WAIT_V(8); PG8_WAIT_L(0); PG8_BAR; PG8_MMA(1, 0, At, B0); PG8_MMA(1, 1, At, B1); PG8_BAR; PG8_SCHED;
            } else {
            PG8_LDB(B0, 0, 0); PG8_SCHED; PG8_LDA(At, 0, 0); PG8_STAGE(PG8_SA(1, 1), a1 + hstep, voffA);
            PG8_WAIT_L(8); PG8_BAR; PG8_WAIT_L(0); PG8_MMA(0, 0, At, B0); PG8_BAR; PG8_SCHED;
            PG8_LDB(B1, 0, 1); PG8_STAGE(PG8_SB(0, 0), b2, voffB);
            PG8_BAR; PG8_WAIT_L(0); PG8_MMA(0, 1, At, B1); PG8_BAR;
            PG8_LDA(At, 0, 1); PG8_STAGE(PG8_SA(0, 0), a2, voffA);
            PG8_BAR; PG8_WAIT_L(0); PG8_MMA(1, 0, At, B0); PG8_BAR; PG8_SCHED;
            PG8_STAGE(PG8_SB(0, 1), b2 + hstep, voffB);
            PG8_WAIT_V(6); PG8_BAR; PG8_MMA(1, 1, At, B1); PG8_BAR;
            PG8_LDB(B0, 1, 0); PG8_SCHED; PG8_LDA(At, 1, 0); PG8_STAGE(PG8_SA(0, 1), a2 + hstep, voffA);
            PG8_WAIT_L(8); PG8_BAR; PG8_WAIT_L(0); PG8_MMA(0, 0, At, B0); PG8_BAR; PG8_SCHED;
            PG8_LDB(B1, 1, 1); PG8_STAGE(PG8_SB(1, 0), b3, voffB);
            PG8_BAR; PG8_WAIT_L(0); PG8_MMA(0, 1, At, B1); PG8_BAR;
            PG8_LDA(At, 1, 1); PG8_STAGE(PG8_SA(1, 0), a3, voffA);
            PG8_BAR; PG8_WAIT_L(0); PG8_MMA(1, 0, At, B0); PG8_BAR; PG8_SCHED;
            PG8_STAGE(PG8_SB(1, 1), b3 + hstep, voffB);
            PG8_WAIT_V(6); PG8_BAR; PG8_MMA(1, 1, At, B1); PG8_BAR;
            }
        }
        if constexpr (ALIGN_EPI) { if (wr == 0) PG8_BAR; }
        if constexpr (!Epi::AFTER_DRAIN) { E(acc, cur, wr, wc, fr, fq); S.done(cur); }
        if (!has_next) break;
#pragma unroll
        for (int a = 0; a < 2; ++a)
#pragma unroll
            for (int b = 0; b < 2; ++b)
#pragma unroll
                for (int m = 0; m < 4; ++m)
#pragma unroll
                    for (int n = 0; n < 2; ++n) acc[a][b][m][n] = (f32x4){0.f, 0.f, 0.f, 0.f};
        cur = nxt; cA = nA; cB = nB; ++ui;
        if constexpr (ALIGN_EPI) { if (wr == 1) PG8_BAR; }
    }
    PG8_WAIT_V(0);
    if constexpr (!ALIGN_EPI) { if (wr == 0) PG8_BAR; }
    PG8_BAR;
    if constexpr (Epi::AFTER_DRAIN) { E.fused(acc, cur, wr, wc, fr, fq, lds, wid, lane); S.done(cur); }
#undef PG8_SA
#undef PG8_SB
#undef PG8_STAGE
#undef PG8_LDA
#undef PG8_LDB
#undef PG8_MMA
#undef PG8_WAIT_V
#undef PG8_WAIT_L
#undef PG8_BAR
#undef PG8_SCHED
}
}

using pg8::bf16_t; using pg8::bf16x8; using pg8::f32x4; using pg8::u32x4;
typedef float f32x16 __attribute__((ext_vector_type(16)));
typedef unsigned u32x2 __attribute__((ext_vector_type(2)));
typedef float f32x2_t __attribute__((ext_vector_type(2)));
typedef __bf16 bf16x2_t __attribute__((ext_vector_type(2)));
#define LAS __attribute__((address_space(3)))
#define DI __device__ __forceinline__
#define WAVE_LDS_SYNC() asm volatile("s_waitcnt lgkmcnt(0)" ::: "memory")
#define MFMA32(a, b, c) __builtin_amdgcn_mfma_f32_32x32x16_bf16((a), (b), (c), 0, 0, 0)

DI unsigned pk2(float lo, float hi) { f32x2_t v = {lo, hi}; bf16x2_t b = __builtin_convertvector(v, bf16x2_t); return __builtin_bit_cast(unsigned, b); }
DI float bflo(unsigned u) { return __uint_as_float(u << 16); }
DI float bfhi(unsigned u) { return __uint_as_float(u & 0xffff0000u); }
DI float bf2f(bf16_t b) { return __uint_as_float((unsigned)b << 16); }
DI bf16_t f2bf(float f) { return (bf16_t)(pk2(f, 0.f) & 0xffffu); }
template <class T> DI T sgpr_pin(T v) { asm volatile("" : "+s"(v)); return v; }
DI int crow(int r, int hi) { return (r & 3) + 8 * (r >> 2) + 4 * hi; }
DI float sigmoidf_(float x) { return 1.f / (1.f + __expf(-x)); }

constexpr int DM = 1024, TP = 4096, TS = 16384, TT = 20480, DFF = 2816, NMODW = 9216;
constexpr int NPE = 768, NPO = 3840;
constexpr float EPS = 1e-6f;
constexpr int NTHREADS = 512, NWAVES = 8;
constexpr int LDS_BYTES = 155648;

constexpr size_t MiB = 1u << 20;
constexpr size_t WS_WFI = 0, WS_WFO = 88 * MiB, WS_WIE = 132 * MiB, WS_WOE = 139 * MiB, WS_WIO = 143 * MiB, WS_WOO = 158 * MiB;
constexpr size_t WS_MOD = 162 * MiB, WS_ROPE = 163 * MiB, WS_DS = 164 * MiB, WS_DP = 228 * MiB;
constexpr size_t WS_CKA = 229 * MiB, WS_CVA = 229 * MiB + 512 * 1024, WS_CKC = 230 * MiB, WS_CVC = 232 * MiB, WS_GATES = 234 * MiB;
constexpr size_t WS_HN = 236 * MiB, WS_ACT = 276 * MiB  , WS_MIX = 426 * MiB, WS_U = 466 * MiB;
constexpr size_t WS_PQT = WS_U, WS_QA = WS_U + 40 * MiB, WS_KA = WS_U + 60 * MiB, WS_PQF = WS_U + 66 * MiB;
constexpr size_t WS_QC = WS_U, WS_KC = WS_U + 20 * MiB, WS_LB = WS_U + 40 * MiB, WS_CPREV = WS_U + 120 * MiB;
constexpr size_t WS_NL = WS_U + 160 * MiB, WS_NPREV = WS_U + 161 * MiB, WS_SCAL = WS_U + 162 * MiB;
constexpr size_t WS_END = WS_U + 163 * MiB;
constexpr size_t WS_O0 = WS_END + MiB, WS_XB = WS_END + 18 * MiB;
constexpr int HPS = 2112, HPP = 192;
constexpr size_t PQF_S0 = (size_t)16 * 512 * 2 * HPP;
constexpr int NUNIT = 640;

constexpr size_t O_KA = 20971520, O_VA = 22020096, O_KC = 23068672, O_VC = 27262976, O_CD = 31457280, O_ND = 35651584, O_MD = 35684352;

struct Args { const float* in[29]; float* out; unsigned char* ws; };

struct EpiSwiglu {
    static constexpr bool PERM = true, AFTER_DRAIN = false;
    bf16_t* O;
    DI void operator()(const f32x4 (&acc)[2][2][4][2], const pg8::Unit& u, int wr, int wc, int fr, int fq) const {
        const int row0 = u.pm * 256 + wr * 64 + fr, col0 = u.pn * 128 + wc * 32 + 8 * fq;
#pragma unroll
        for (int ai = 0; ai < 2; ++ai)
#pragma unroll
            for (int m = 0; m < 4; ++m) {
                bf16_t* rowp = O + (size_t)(row0 + ai * 128 + m * 16) * DFF + col0;
                float v[8];
#pragma unroll
                for (int n = 0; n < 2; ++n)
#pragma unroll
                    for (int e = 0; e < 4; ++e) { const float g = acc[ai][0][m][n][e], up = acc[ai][1][m][n][e]; v[n * 4 + e] = g * up * __builtin_amdgcn_rcpf(1.f + __expf(-g)); }
                u32x4 w; w.x = pk2(v[0], v[1]); w.y = pk2(v[2], v[3]); w.z = pk2(v[4], v[5]); w.w = pk2(v[6], v[7]);
                *(u32x4*)rowp = w;
            }
    }
};
struct EpiResid {
    static constexpr bool PERM = true, AFTER_DRAIN = false;
    bf16_t* XB; float* Xout; const float* Rp; const float* Rs; const float* modg; float coef; int mode;
    DI void operator()(const f32x4 (&acc)[2][2][4][2], const pg8::Unit& u, int wr, int wc, int fr, int fq) const {
        const int v = u.pm < 16 ? 0 : 1 + ((u.pm - 16) >> 4);
        const int col0 = u.pn * 256 + wc * 32 + 8 * fq, row0 = u.pm * 256 + wr * 64 + fr;
        const float* R = u.pm < 16 ? Rp : Rs - (size_t)TP * DM;
        const bool rin = (mode & 1) != 0, wout = (mode & 2) != 0;
#pragma unroll
        for (int bj = 0; bj < 2; ++bj) {
            const f32x4 g0 = *(const f32x4*)(modg + (size_t)v * NMODW + col0 + bj * 128) * coef, g1 = *(const f32x4*)(modg + (size_t)v * NMODW + col0 + bj * 128 + 4) * coef;
#pragma unroll
            for (int ai = 0; ai < 2; ++ai) {
                if (!(u.qm & (1 << (2 * ai + bj)))) continue;
                f32x4 x0[4], x1[4];
                if (rin) {
#pragma unroll
                    for (int m = 0; m < 4; ++m) { const float* p = R + (size_t)(row0 + ai * 128 + m * 16) * DM + col0 + bj * 128; x0[m] = *(const f32x4*)p; x1[m] = *(const f32x4*)(p + 4); }
                } else {
                    u32x4 xr[4];
#pragma unroll
                    for (int m = 0; m < 4; ++m) xr[m] = *(const u32x4*)(XB + (size_t)(row0 + ai * 128 + m * 16) * DM + col0 + bj * 128);
#pragma unroll
                    for (int m = 0; m < 4; ++m) { x0[m] = (f32x4){bflo(xr[m].x), bfhi(xr[m].x), bflo(xr[m].y), bfhi(xr[m].y)}; x1[m] = (f32x4){bflo(xr[m].z), bfhi(xr[m].z), bflo(xr[m].w), bfhi(xr[m].w)}; }
                }
#pragma unroll
                for (int m = 0; m < 4; ++m) {
                    const size_t off = (size_t)(row0 + ai * 128 + m * 16) * DM + col0 + bj * 128;
                    const f32x4 y0 = x0[m] + g0 * acc[ai][bj][m][0], y1 = x1[m] + g1 * acc[ai][bj][m][1];
                    if (wout) { *(f32x4*)(Xout + off) = y0; *(f32x4*)(Xout + off + 4) = y1; }
                    else { u32x4 w; w.x = pk2(y0[0], y0[1]); w.y = pk2(y0[2], y0[3]); w.z = pk2(y1[0], y1[1]); w.w = pk2(y1[2], y1[3]); *(u32x4*)(XB + off) = w; }
                }
            }
        }
    }
};
template <int MODE> struct EpiStore {
    static constexpr bool PERM = true, AFTER_DRAIN = false;
    bf16_t* O; int ldc; float scale; float* gates; int tokbase; int S;
    DI void operator()(const f32x4 (&acc)[2][2][4][2], const pg8::Unit& u, int wr, int wc, int fr, int fq) const {
#pragma unroll
        for (int ai = 0; ai < 2; ++ai)
#pragma unroll
            for (int m = 0; m < 4; ++m) {
                const int row = u.pm * 256 + ai * 128 + wr * 64 + m * 16 + fr;
#pragma unroll
                for (int bj = 0; bj < 2; ++bj) {
                    const int cin = bj * 128 + wc * 32 + 8 * fq;
                    f32x4 v0 = acc[ai][bj][m][0], v1 = acc[ai][bj][m][1];
                    bf16_t* p;
                    if (MODE == 0) { p = O + (size_t)row * ldc + u.pn * 256 + cin; }
                    else if (MODE == 1) {
                        const int g = row >> 8, which = (row >> 7) & 1, j = row & 127, tok = u.pn * 256 + cin;
                        if (tok < TP) { const int b = tok >> 8, s = tok & 255; p = O + ((size_t)((b * 512 + g * 128 + j) * 2 + which) * 256 + s); }
                        else { const int t2 = tok - TP, b = t2 >> 12, s = t2 & 4095; p = O + (size_t)4194304 + ((size_t)((b * 512 + g * 128 + j) * 2 + which) * 4096 + s); }
                    } else {
                        const int b = u.pn >> 1, cn = (u.pn & 1) * 256 + cin;
                        p = O + (size_t)(tokbase + b * S + row) * DM + 512 + cn;
                        v0 *= scale; v1 *= scale;
                    }
                    u32x4 w; w.x = pk2(v0[0], v0[1]); w.y = pk2(v0[2], v0[3]); w.z = pk2(v1[0], v1[1]); w.w = pk2(v1[2], v1[3]);
                    *(u32x4*)p = w;
                    if (MODE == 0) { if (ldc == NPO && u.pn == 14 && bj == 0 && wc == 0 && fq < 2) {
                        float* gp = gates + (size_t)row * 16 + 8 * fq;
                        *(f32x4*)gp = acc[ai][bj][m][0]; *(f32x4*)(gp + 4) = acc[ai][bj][m][1];
                    } }
                }
            }
    }
};
struct EpiResidTail {
    static constexpr bool PERM = false, AFTER_DRAIN = true;
    EpiResid base; float* tmp; unsigned* flag; int khalf;
    DI void fused(f32x4 (&acc)[2][2][4][2], const pg8::Unit& u, int wr, int wc, int fr, int fq, LAS unsigned char*, int, int) const {
        float* const t0 = sgpr_pin(tmp) + (size_t)(wr * 64 + fr) * 256 + wc * 32 + 4 * fq;
        if (khalf == 1) {
#pragma unroll
            for (int ai = 0; ai < 2; ++ai)
#pragma unroll
                for (int m = 0; m < 4; ++m)
#pragma unroll
                    for (int bj = 0; bj < 2; ++bj)
#pragma unroll
                        for (int n = 0; n < 2; ++n) *(f32x4*)(t0 + (size_t)(ai * 128 + m * 16) * 256 + bj * 128 + n * 16) = acc[ai][bj][m][n];
            asm volatile("s_waitcnt vmcnt(0)" ::: "memory");
            __syncthreads();
            if (threadIdx.x == 0) { __builtin_amdgcn_fence(__ATOMIC_RELEASE, "agent"); asm volatile("s_waitcnt vmcnt(0)" ::: "memory"); __hip_atomic_store(flag, 1u, __ATOMIC_RELAXED, __HIP_MEMORY_SCOPE_AGENT); }
        } else {
            if (threadIdx.x == 0) {
                unsigned sp = 0;
                while (__hip_atomic_load(flag, __ATOMIC_RELAXED, __HIP_MEMORY_SCOPE_AGENT) == 0u) { __builtin_amdgcn_s_sleep(2); if (++sp > (1u << 18)) break; }
                __builtin_amdgcn_fence(__ATOMIC_ACQUIRE, "agent"); asm volatile("s_waitcnt vmcnt(0)" ::: "memory");
            }
            __syncthreads();
#pragma unroll
            for (int ai = 0; ai < 2; ++ai)
#pragma unroll
                for (int m = 0; m < 4; ++m)
                {
#pragma unroll
                    for (int bj = 0; bj < 2; ++bj)
#pragma unroll
                        for (int n = 0; n < 2; ++n) acc[ai][bj][m][n] += *(const f32x4*)(t0 + (size_t)(ai * 128 + m * 16) * 256 + bj * 128 + n * 16);
                    asm volatile("" : "+v"(acc[ai][0][m][0]), "+v"(acc[ai][0][m][1]), "+v"(acc[ai][1][m][0]), "+v"(acc[ai][1][m][1]) :: "memory");
                }
            base(acc, u, wr, wc, fr, fq);
        }
    }
};
struct FullRounds {
    pg8::StaticOrder so; int nfr;
    DI void init(int M, int N, int G, int c) { so.init(M, N, G, c); nfr = so.nwg / G; }
    DI bool next(int i, pg8::Unit& u) const { return i < nfr && so.next(i, u); }
    DI void a_ready(const pg8::Unit&) const {}
    DI void done(const pg8::Unit&) const {}
};
struct HalfTail {
    pg8::StaticOrder so; int uidx;
    DI void init(int M, int N, int G, int c) { so.init(M, N, G, c); const int nfr = so.nwg / G, rem = so.nwg - nfr * G; uidx = c < 2 * rem ? nfr * G + (c >> 1) : -1; }
    DI bool next(int i, pg8::Unit& u) const { if (i != 0 || uidx < 0) return false; pg8::StaticOrder t = so; t.c = uidx; t.G = 0; return t.next(0, u); }
    DI void a_ready(const pg8::Unit&) const {}
    DI void done(const pg8::Unit&) const {}
};
struct TailOrder {
    pg8::StaticOrder so; int nfr, rem;
    DI void init(int M, int N, int G, int c) { so.init(M, N, G, c); nfr = so.nwg / G; rem = so.nwg - nfr * G; }
    DI bool next(int i, pg8::Unit& u) const {
        if (i < nfr) return so.next(i, u);
        const int j = (i - nfr) * so.G + so.c; if (j >= rem * 4) return false;
        pg8::StaticOrder t = so; t.c = nfr * so.G + (j >> 2) - 0; t.G = 0;
        t.next(0, u); u.qm = 1 << (j & 3); return true; }
    DI void a_ready(const pg8::Unit&) const {}
    DI void done(const pg8::Unit&) const {}
};
struct SimpleOrder {
    int nM, nN, G, c, sq;
    DI bool next(int i, pg8::Unit& u) const { const int idx = i * G + c; if (idx >= nM * nN) return false;
        if (sq && nM == 16 && nN == 8) { const int x = idx & 7, j = idx >> 3; u.pm = (x & 3) * 4 + (j & 3); u.pn = (x >> 2) * 4 + (j >> 2); }
        else { u.pm = idx % nM; u.pn = idx / nM; }
        u.qm = 15; return true; }
    DI void a_ready(const pg8::Unit&) const {}
    DI void done(const pg8::Unit&) const {}
};

DI void transpose_item(const float* W, int K, int ldw, int N, int Npad, bf16_t* WT, int mode, LAS float* scr, int item, int lane) {
    const int nblk = Npad / 32, kb = item / nblk, nb = item - kb * nblk, k0 = 64 * kb, n0 = 32 * nb;
    const int n = n0 + (lane & 31);
    float tv[32];
#pragma unroll
    for (int i = 0; i < 32; ++i) { const int kk = 2 * i + (lane >> 5); tv[i] = (n < N) ? __builtin_nontemporal_load(W + (size_t)(k0 + kk) * ldw + n) : 0.f; }
#pragma unroll
    for (int i = 0; i < 32; ++i) { const int kk = 2 * i + (lane >> 5); scr[kk * 33 + (lane & 31)] = tv[i]; }
    WAVE_LDS_SYNC();
    const int c = lane & 7;
#pragma unroll
    for (int j = 0; j < 4; ++j) {
        const int nl = (lane >> 3) + 8 * j, nn = n0 + nl;
        const LAS float* s = scr + (8 * c) * 33 + nl;
        float sc = 1.f; int row = nn;
        if (mode == 1) { const int half = nn >= DFF ? 1 : 0, jj = nn - half * DFF; row = (jj >> 7) * 256 + half * 128 + (jj & 127); }
        else if (mode == 2) { if (nn >= 2048 && nn < 2560) sc = 0.08838834764831845f; }
        u32x4 o; o.x = pk2(s[0] * sc, s[33] * sc); o.y = pk2(s[66] * sc, s[99] * sc); o.z = pk2(s[132] * sc, s[165] * sc); o.w = pk2(s[198] * sc, s[231] * sc);
        *(u32x4*)(WT + (size_t)row * K + k0 + 8 * c) = o;
    }
    WAVE_LDS_SYNC();
}

DI void prepass(const Args& a, LAS unsigned char* lds) {
    const int tid = tid_opaque(), lane = tid & 63, wid = tid >> 6, G = gridDim.x;
    unsigned char* ws = a.ws;
#define PRE_GT() const size_t gt = (size_t)bid_opaque() * NTHREADS + tid_opaque(), NGT = (size_t)G * NTHREADS
    {
        PRE_GT();
        const size_t n4[4] = {262144 / 4, 262144 / 4, 1048576 / 4, 1048576 / 4};
        const size_t offs[4] = {WS_CKA, WS_CVA, WS_CKC, WS_CVC};
#pragma unroll
        for (int q = 0; q < 4; ++q) {
            const f32x4* src = (const f32x4*)a.in[3 + q]; u32x2* dst = (u32x2*)(ws + offs[q]);
            for (size_t i = gt; i < n4[q]; i += NGT) { const f32x4 v = src[i]; u32x2 w; w.x = pk2(v[0], v[1]); w.y = pk2(v[2], v[3]); dst[i] = w; }
        }
    }
    {
        PRE_GT();
        float* R = (float*)(ws + WS_ROPE);
        for (size_t i = gt; i < 4096 * 32; i += NGT) {
            const int pos = (int)(i >> 5), af = (int)(i & 31), ax = af >> 4, f = af & 15;
            const float inv = exp2f(-(float)f * (13.287712379549449f / 16.f));
            const float ang = (float)(ax == 0 ? (pos >> 6) : (pos & 63)) * inv;
            R[pos * 64 + af] = __cosf(ang); R[pos * 64 + 32 + af] = __sinf(ang);
        }
    }
    {
        PRE_GT();
        u32x4* D = (u32x4*)(ws + WS_DS);
        for (size_t it = gt; it < (size_t)4096 * (2 * HPS / 8); it += NGT) {
            const int k = (int)(it / (2 * HPS / 8)), c8 = (int)(it - (size_t)k * (2 * HPS / 8)) * 8; float v[8];
#pragma unroll
            for (int e = 0; e < 8; ++e) { const int c = c8 + e, part = c >= HPS ? 1 : 0, cc = c - part * HPS; int idx = (k * cc) & 4095; if (idx >= 2048) idx -= 4096; const float ang = (float)idx * (6.283185307179586f / 4096.f);
                v[e] = cc <= 2048 ? (part ? -__sinf(ang) : __cosf(ang)) : 0.f; }
            u32x4 w; w.x = pk2(v[0], v[1]); w.y = pk2(v[2], v[3]); w.z = pk2(v[4], v[5]); w.w = pk2(v[6], v[7]); D[it] = w;
        }
        u32x4* Dp = (u32x4*)(ws + WS_DP);
        for (size_t it = gt; it < (size_t)256 * (2 * HPP / 8); it += NGT) {
            const int k = (int)(it / (2 * HPP / 8)), c8 = (int)(it - (size_t)k * (2 * HPP / 8)) * 8; float v[8];
#pragma unroll
            for (int e = 0; e < 8; ++e) { const int c = c8 + e, part = c >= HPP ? 1 : 0, cc = c - part * HPP; int idx = (k * cc) & 255; if (idx >= 128) idx -= 256; const float ang = (float)idx * (6.283185307179586f / 256.f);
                v[e] = cc <= 128 ? (part ? -__sinf(ang) : __cosf(ang)) : 0.f; }
            u32x4 w; w.x = pk2(v[0], v[1]); w.y = pk2(v[2], v[3]); w.z = pk2(v[4], v[5]); w.w = pk2(v[6], v[7]); Dp[it] = w;
        }
    }
    {
        const int gw = bid_opaque() * NWAVES + wid, NGW = G * NWAVES;
        LAS float* scr = (LAS float*)(lds + wid * 8448);
        constexpr int I_FI = 2816, I_FO = 1408, I_IE = 384, I_OE = 512, I_IO = 1920, I_OO = 512;
        constexpr int NIT = 8 * I_FI + 8 * I_FO + 2 * I_IE + 2 * I_OE + 2 * I_IO + 2 * I_OO;
        for (int it = gw; it < NIT; it += NGW) {
            int r = it;
            if (r < 8 * I_FI) { const int mi = r / I_FI; transpose_item(a.in[14] + (size_t)mi * DM * 2 * DFF, DM, 2 * DFF, 2 * DFF, 2 * DFF, (bf16_t*)(ws + WS_WFI) + (size_t)mi * 2 * DFF * DM, 1, scr, r - mi * I_FI, lane); continue; } r -= 8 * I_FI;
            if (r < 8 * I_FO) { const int mi = r / I_FO; transpose_item(a.in[15] + (size_t)mi * DFF * DM, DFF, DM, DM, DM, (bf16_t*)(ws + WS_WFO) + (size_t)mi * DM * DFF, 0, scr, r - mi * I_FO, lane); continue; } r -= 8 * I_FO;
            if (r < 2 * I_IE) { const int mi = r / I_IE; transpose_item(a.in[16] + (size_t)mi * DM * 1280, DM, 1280, 768, 768, (bf16_t*)(ws + WS_WIE) + (size_t)mi * 1792 * DM, 0, scr, r - mi * I_IE, lane); continue; } r -= 2 * I_IE;
            if (r < 2 * I_OE) { const int mi = r / I_OE; transpose_item(a.in[17] + (size_t)mi * DM * DM, DM, DM, DM, DM, (bf16_t*)(ws + WS_WOE) + (size_t)mi * DM * DM, 0, scr, r - mi * I_OE, lane); continue; } r -= 2 * I_OE;
            if (r < 2 * I_IO) { const int mi = r / I_IO; transpose_item(a.in[21] + (size_t)mi * DM * 3600, DM, 3600, 3600, NPO, (bf16_t*)(ws + WS_WIO) + (size_t)mi * NPO * DM, 2, scr, r - mi * I_IO, lane); continue; } r -= 2 * I_IO;
            { const int mi = r / I_OO; transpose_item(a.in[23] + (size_t)mi * DM * DM, DM, DM, DM, DM, (bf16_t*)(ws + WS_WOO) + (size_t)mi * DM * DM, 0, scr, r - mi * I_OO, lane); }
        }
    }
    __syncthreads();
    {
        LAS float* Wl = (LAS float*)lds; LAS float* tab = Wl + 64 * 129;
        for (int it = bid_opaque(); it < 128; it += G) {
            const int li = it >> 6, g = (it >> 4) & 3, kb = it & 15;
            const float* Wsrc = a.in[16] + (size_t)li * DM * 1280;
            for (int e = tid; e < 64 * 128; e += NTHREADS) { const int k = e >> 7, c = e & 127; Wl[k * 129 + c] = Wsrc[(size_t)(kb * 64 + k) * 1280 + 768 + g * 128 + c]; }
            if (tid < 128) { const float ang = (float)tid * (6.283185307179586f / 128.f); tab[tid] = __cosf(ang); tab[128 + tid] = __sinf(ang); }
            __syncthreads();
            const int k = tid & 63, nb = tid >> 6;
            bf16_t* dst = (bf16_t*)(ws + WS_WIE) + (size_t)li * 1792 * DM;
#pragma unroll 1
            for (int ii = 0; ii < 32; ++ii) {
                const int n = nb + 8 * ii, which = n >> 7, j = n & 127; float acc = 0.f;
#pragma unroll 8
                for (int c = 0; c < 128; ++c) acc += Wl[k * 129 + c] * tab[which * 128 + ((c * j) & 127)];
                dst[(size_t)(768 + g * 256 + n) * DM + kb * 64 + k] = f2bf(acc);
            }
            __syncthreads();
        }
    }
    {
        LAS float* S5 = (LAS float*)lds; LAS float* part = S5 + 5120;
        for (int e = tid; e < 5120; e += NTHREADS) { const int v = e >> 10, k = e & 1023; const float x = v == 0 ? a.in[10][k] : a.in[2][(v - 1) * 1024 + k]; S5[e] = x / (1.f + __expf(-x)); }
        __syncthreads();
        float* MOD = (float*)(ws + WS_MOD);
        for (int it = bid_opaque(); it < 576; it += G) {
            const int l = it / 144, cgp = it - l * 144, n = cgp * 64 + lane;
            float acc[5] = {0.f, 0.f, 0.f, 0.f, 0.f};
            const float* W = a.in[11] + ((size_t)l * DM + wid * 128) * NMODW + n;
#pragma unroll 1
            for (int k8 = 0; k8 < 128; k8 += 16) {
                float wv[16];
#pragma unroll
                for (int q = 0; q < 16; ++q) wv[q] = __builtin_nontemporal_load(W + (size_t)(k8 + q) * NMODW);
#pragma unroll
                for (int q = 0; q < 16; ++q)
#pragma unroll
                    for (int v = 0; v < 5; ++v) acc[v] += S5[v * 1024 + wid * 128 + k8 + q] * wv[q];
            }
#pragma unroll
            for (int v = 0; v < 5; ++v) part[(wid * 5 + v) * 64 + lane] = acc[v];
            __syncthreads();
            if (tid < 320) { const int v = tid >> 6, ln = tid & 63; float s = a.in[12][(size_t)l * NMODW + cgp * 64 + ln];
#pragma unroll
                for (int w = 0; w < 8; ++w) s += part[(w * 5 + v) * 64 + ln];
                MOD[((size_t)l * 5 + v) * NMODW + cgp * 64 + ln] = s; }
            __syncthreads();
        }
    }
}

DI void norm_row(int row, int lane, const float* Xp, const float* Xs, bf16_t* HN, const float* g, const float* modl, int j) {
    const int v = row < TP ? 0 : 1 + ((row - TP) >> 12);
    const f32x4* xr = (const f32x4*)(row < TP ? Xp + (size_t)row * DM : Xs + (size_t)(row - TP) * DM) + lane;
    const f32x4* gr = (const f32x4*)g + lane;
    const f32x4* sh = (const f32x4*)(modl + (size_t)v * NMODW + (3 * j) * DM) + lane;
    const f32x4* sc = (const f32x4*)(modl + (size_t)v * NMODW + (3 * j + 1) * DM) + lane;
    f32x4 x[4]; float ss = 0.f;
#pragma unroll
    for (int q = 0; q < 4; ++q) { x[q] = xr[64 * q]; ss += (x[q][0] * x[q][0] + x[q][1] * x[q][1]) + (x[q][2] * x[q][2] + x[q][3] * x[q][3]); }
#pragma unroll
    for (int o = 1; o < 64; o <<= 1) ss += __shfl_xor(ss, o);
    const float rinv = rsqrtf(ss * (1.f / DM) + EPS);
    u32x2* o8 = (u32x2*)(HN + (size_t)row * DM) + lane;
#pragma unroll
    for (int q = 0; q < 4; ++q) { const f32x4 y = x[q] * rinv * gr[64 * q] * (sc[64 * q] + 1.f) + sh[64 * q]; u32x2 w; w.x = pk2(y[0], y[1]); w.y = pk2(y[2], y[3]); o8[64 * q] = w; }
}
DI void norm_phase(const float* Xp, const float* Xs, const bf16_t* XB, bf16_t* HN, const float* g, const float* modl, int j) {
    const int tid = tid_opaque(), lane = tid & 63, wid = tid >> 6;
    const int gw = bid_opaque() * NWAVES + wid, NGW = gridDim.x * NWAVES;
    for (int row = gw; row < TT; row += 2 * NGW) {
        const int rowb0 = row + NGW; const bool hb = rowb0 < TT; const int rowb = hb ? rowb0 : row;
        f32x4 x[4], y[4];
        if (XB != nullptr) {
            const u32x2* xa = (const u32x2*)(XB + (size_t)row * DM) + lane; const u32x2* xb = (const u32x2*)(XB + (size_t)rowb * DM) + lane;
            u32x2 ra[4], rb[4];
#pragma unroll
            for (int q = 0; q < 4; ++q) { ra[q] = xa[64 * q]; rb[q] = xb[64 * q]; }
#pragma unroll
            for (int q = 0; q < 4; ++q) { x[q] = (f32x4){bflo(ra[q].x), bfhi(ra[q].x), bflo(ra[q].y), bfhi(ra[q].y)}; y[q] = (f32x4){bflo(rb[q].x), bfhi(rb[q].x), bflo(rb[q].y), bfhi(rb[q].y)}; }
        } else {
            const f32x4* xa = (const f32x4*)(row < TP ? Xp + (size_t)row * DM : Xs + (size_t)(row - TP) * DM) + lane;
            const f32x4* xb = (const f32x4*)(rowb < TP ? Xp + (size_t)rowb * DM : Xs + (size_t)(rowb - TP) * DM) + lane;
#pragma unroll
            for (int q = 0; q < 4; ++q) { x[q] = xa[64 * q]; y[q] = xb[64 * q]; }
        }
        float ss = 0.f, st = 0.f;
#pragma unroll
        for (int q = 0; q < 4; ++q) { ss += (x[q][0] * x[q][0] + x[q][1] * x[q][1]) + (x[q][2] * x[q][2] + x[q][3] * x[q][3]); st += (y[q][0] * y[q][0] + y[q][1] * y[q][1]) + (y[q][2] * y[q][2] + y[q][3] * y[q][3]); }
#pragma unroll
        for (int o = 1; o < 64; o <<= 1) { ss += __shfl_xor(ss, o); st += __shfl_xor(st, o); }
        const f32x4* gr = (const f32x4*)g + lane;
#pragma unroll
        for (int h = 0; h < 2; ++h) {
            if (h == 1 && !hb) break;
            const int r = h ? rowb : row; const int v = r < TP ? 0 : 1 + ((r - TP) >> 12);
            const f32x4* sh = (const f32x4*)(modl + (size_t)v * NMODW + (3 * j) * DM) + lane;
            const f32x4* sc = (const f32x4*)(modl + (size_t)v * NMODW + (3 * j + 1) * DM) + lane;
            const float rinv = rsqrtf((h ? st : ss) * (1.f / DM) + EPS);
            u32x2* o8 = (u32x2*)(HN + (size_t)r * DM) + lane;
#pragma unroll
            for (int q = 0; q < 4; ++q) { const f32x4 z = (h ? y[q] : x[q]) * rinv * gr[64 * q] * (sc[64 * q] + 1.f) + sh[64 * q]; u32x2 w; w.x = pk2(z[0], z[1]); w.y = pk2(z[2], z[3]); o8[64 * q] = w; }
        }
    }
}
DI void norm_after_resid(unsigned* cnt, const float* X, bf16_t* HN, const float* g, const float* modl, int j) {
    const int tid = tid_opaque(), lane = tid & 63, wid = tid >> 6, G = gridDim.x, c = bid_opaque();
    const int r0 = (int)((long)TT * c / G), r1 = (int)((long)TT * (c + 1) / G);
    if (tid == 0) {
        for (int p = r0 >> 8; p <= (r1 - 1) >> 8; ++p) {
            unsigned sp = 0;
            while (__hip_atomic_load(cnt + p, __ATOMIC_RELAXED, __HIP_MEMORY_SCOPE_AGENT) < 4u) { __builtin_amdgcn_s_sleep(2); if (++sp > (1u << 18)) break; }
        }
        __builtin_amdgcn_fence(__ATOMIC_ACQUIRE, "agent"); asm volatile("s_waitcnt vmcnt(0)" ::: "memory");
    }
    __syncthreads();
    for (int row = r0 + wid; row < r1; row += NWAVES) norm_row(row, lane, X, X + (size_t)TP * DM, HN, g, modl, j);
}

DI void normrope_block(const u32x4 raw, int nact, const float* gw64, bool rope, const float* ropetab, bf16_t* dst, float* dst32, int lane) {
    float x[8];
    if (lane < nact) { x[0] = bflo(raw.x); x[1] = bfhi(raw.x); x[2] = bflo(raw.y); x[3] = bfhi(raw.y); x[4] = bflo(raw.z); x[5] = bfhi(raw.z); x[6] = bflo(raw.w); x[7] = bfhi(raw.w); }
    else {
#pragma unroll
        for (int e = 0; e < 8; ++e) x[e] = 0.f; }
    float ss = 0.f;
#pragma unroll
    for (int e = 0; e < 8; ++e) ss += x[e] * x[e];
    ss += __shfl_xor(ss, 1); ss += __shfl_xor(ss, 2); ss += __shfl_xor(ss, 4);
    const float rinv = rsqrtf(ss * (1.f / 64.f) + EPS);
    const int j = lane & 7;
    float y[8];
#pragma unroll
    for (int e = 0; e < 8; ++e) y[e] = x[e] * rinv * gw64[8 * j + e];
    if (dst32 != nullptr && lane < nact) { *(f32x4*)(dst32 + 8 * lane) = (f32x4){y[0], y[1], y[2], y[3]}; *(f32x4*)(dst32 + 8 * lane + 4) = (f32x4){y[4], y[5], y[6], y[7]}; }
    if (rope) {
        const int ax = j >> 2, half = (j >> 1) & 1, f0 = 8 * (j & 1);
#pragma unroll
        for (int e = 0; e < 8; ++e) {
            const float c = ropetab[ax * 16 + f0 + e], s = ropetab[32 + ax * 16 + f0 + e];
            const float p = __shfl_xor(y[e], 2);
            y[e] = half == 0 ? (y[e] * c - p * s) : (p * s + y[e] * c);
        }
    }
    if (lane < nact) { u32x4 w; w.x = pk2(y[0], y[1]); w.y = pk2(y[2], y[3]); w.z = pk2(y[4], y[5]); w.w = pk2(y[6], y[7]); *(u32x4*)(dst + 8 * lane) = w; }
}
DI void postproj_even(const Args& a, int li) {
    const int tid = tid_opaque(), lane = tid & 63, wid = tid >> 6;
    const int gw = bid_opaque() * NWAVES + wid, NGW = gridDim.x * NWAVES;
    unsigned char* ws = a.ws;
    const bf16_t* P = (const bf16_t*)(ws + WS_ACT); bf16_t* QA = (bf16_t*)(ws + WS_QA); bf16_t* KA = (bf16_t*)(ws + WS_KA);
    const float* ROPE = (const float*)(ws + WS_ROPE);
    const float* qn = a.in[18] + li * 64; const float* kn = a.in[19] + li * 64;
    u32x4 rq = {0, 0, 0, 0}, rk = {0, 0, 0, 0}, rv = {0, 0, 0, 0};
    if (gw < TT) { const bf16_t* pr = P + (size_t)gw * NPE; rq = *(const u32x4*)(pr + 8 * lane); if (lane < 16) { rk = *(const u32x4*)(pr + 512 + 8 * lane); rv = *(const u32x4*)(pr + 640 + 8 * lane); } }
    for (int row = gw; row < TT; row += NGW) {
        u32x4 nq = {0, 0, 0, 0}, nk = {0, 0, 0, 0}, nv = {0, 0, 0, 0};
        if (row + NGW < TT) { const bf16_t* pn = P + (size_t)(row + NGW) * NPE; nq = *(const u32x4*)(pn + 8 * lane); if (lane < 16) { nk = *(const u32x4*)(pn + 512 + 8 * lane); nv = *(const u32x4*)(pn + 640 + 8 * lane); } }
        const bool smp = row >= TP; const int pos = smp ? ((row - TP) & 4095) : 0;
        const float* rt = ROPE + (size_t)pos * 64;
        float* ko = nullptr;
        if (!smp) { const int b = row >> 8, s = row & 255; ko = a.out + O_KA + ((size_t)(b * 2 + li) * 256 + s) * 128; }
        normrope_block(rq, 64, qn, smp, rt, QA + (size_t)row * 512, nullptr, lane);
        normrope_block(rk, 16, kn, smp, rt, KA + (size_t)row * 128, ko, lane);
        if (!smp && lane < 16) {
            const int b = row >> 8, s = row & 255; float* vo = a.out + O_VA + ((size_t)(b * 2 + li) * 256 + s) * 128 + 8 * lane;
            *(f32x4*)vo = (f32x4){bflo(rv.x), bfhi(rv.x), bflo(rv.y), bfhi(rv.y)}; *(f32x4*)(vo + 4) = (f32x4){bflo(rv.z), bfhi(rv.z), bflo(rv.w), bfhi(rv.w)};
        }
        rq = nq; rk = nk; rv = nv;
    }
    {
        const bf16_t* PQT = (const bf16_t*)(ws + WS_PQT); bf16_t* PQF = (bf16_t*)(ws + WS_PQF);
        const size_t gt = (size_t)bid_opaque() * NTHREADS + tid_opaque(), NGT = (size_t)gridDim.x * NTHREADS;
        const size_t nS = (size_t)4 * 512 * 2 * (HPS / 8), nP = (size_t)16 * 512 * 2 * (HPP / 8);
        for (size_t it = gt; it < nS + nP; it += NGT) {
            const bool smp = it < nS; const size_t i2 = smp ? it : it - nS;
            const int HP = smp ? HPS : HPP, S = smp ? 4096 : 256, nch = HP / 8;
            const size_t rw = i2 / nch; const int c8 = (int)(i2 - rw * nch) * 8, which = (int)(rw & 1);
            const bf16_t* src = PQT + (smp ? (size_t)4194304 : 0) + rw * S;
            bf16_t* dst = PQF + (smp ? PQF_S0 : 0) + rw * HP + c8;
            float v[8];
            if (c8 > S / 2) {
#pragma unroll
                for (int e = 0; e < 8; ++e) v[e] = 0.f;
            } else {
                const u32x4 raw = *(const u32x4*)(src + c8);
                const u32x4 mir = *(const u32x4*)(src + S - c8 - 8);
                const float ym0 = c8 > 0 ? bf2f(src[S - c8]) : 0.f;
                const float x[8] = {bflo(raw.x), bfhi(raw.x), bflo(raw.y), bfhi(raw.y), bflo(raw.z), bfhi(raw.z), bflo(raw.w), bfhi(raw.w)};
                const float y[8] = {ym0, bfhi(mir.w), bflo(mir.w), bfhi(mir.z), bflo(mir.z), bfhi(mir.y), bflo(mir.y), bfhi(mir.x)};
#pragma unroll
                for (int e = 0; e < 8; ++e) {
                    const int s = c8 + e;
                    if (s == 0 || s == S / 2) v[e] = which ? 0.f : x[e];
                    else if (s > S / 2) v[e] = 0.f;
                    else v[e] = which ? x[e] - y[e] : x[e] + y[e];
                }
            }
            u32x4 w; w.x = pk2(v[0], v[1]); w.y = pk2(v[2], v[3]); w.z = pk2(v[4], v[5]); w.w = pk2(v[6], v[7]); *(u32x4*)dst = w;
        }
    }
}
DI void postproj_odd(const Args& a, int li) {
    const int tid = tid_opaque(), lane = tid & 63, wid = tid >> 6;
    const int gw = bid_opaque() * NWAVES + wid, NGW = gridDim.x * NWAVES;
    unsigned char* ws = a.ws;
    const bf16_t* P = (const bf16_t*)(ws + WS_ACT); bf16_t* QC = (bf16_t*)(ws + WS_QC); bf16_t* KC = (bf16_t*)(ws + WS_KC);
    const float* ROPE = (const float*)(ws + WS_ROPE);
    const float* qn = a.in[24] + li * 64; const float* kn = a.in[25] + li * 64;
    u32x4 rq = {0, 0, 0, 0}, rk = {0, 0, 0, 0}, rv = {0, 0, 0, 0};
    if (gw < TT) { const bf16_t* pr = P + (size_t)gw * NPO; rq = *(const u32x4*)(pr + 8 * lane); rk = *(const u32x4*)(pr + 512 + 8 * lane); if (gw < TP) rv = *(const u32x4*)(pr + 1024 + 8 * lane); }
    for (int row = gw; row < TT; row += NGW) {
        u32x4 nq = {0, 0, 0, 0}, nk = {0, 0, 0, 0}, nv = {0, 0, 0, 0};
        if (row + NGW < TT) { const bf16_t* pn = P + (size_t)(row + NGW) * NPO; nq = *(const u32x4*)(pn + 8 * lane); nk = *(const u32x4*)(pn + 512 + 8 * lane); if (row + NGW < TP) nv = *(const u32x4*)(pn + 1024 + 8 * lane); }
        const bool smp = row >= TP; const int pos = smp ? ((row - TP) & 4095) : 0;
        const float* rt = ROPE + (size_t)pos * 64;
        float* ko = nullptr;
        if (!smp) { const int b = row >> 8, s = row & 255; ko = a.out + O_KC + ((size_t)(b * 2 + li) * 256 + s) * 512; }
        normrope_block(rq, 64, qn, smp, rt, QC + (size_t)row * 512, nullptr, lane);
        normrope_block(rk, 64, kn, smp, rt, KC + (size_t)row * 512, ko, lane);
        if (!smp) {
            const int b = row >> 8, s = row & 255; float* vo = a.out + O_VC + ((size_t)(b * 2 + li) * 256 + s) * 512 + 8 * lane;
            *(f32x4*)vo = (f32x4){bflo(rv.x), bfhi(rv.x), bflo(rv.y), bfhi(rv.y)}; *(f32x4*)(vo + 4) = (f32x4){bflo(rv.z), bfhi(rv.z), bflo(rv.w), bfhi(rv.w)};
        }
        rq = nq; rk = nk; rv = nv;
    }
}
#define XB_TMO      128
#define XB_XCNT(j)  (256  + 64 * (j))
#define XB_XSUB(j)  (1280 + 64 * (j))
#define XB_XGEN(j)  (2304 + 64 * (j))
#define XB_TOP      3328
#define XB_TOPGEN   3392
#define XCD_BAR_WORDS 3456
#define XB_SPIN_CAP (1u << 18)

__device__ __forceinline__ unsigned xb_ld(unsigned* p)              { return __hip_atomic_load(p, __ATOMIC_RELAXED, __HIP_MEMORY_SCOPE_AGENT); }
__device__ __forceinline__ unsigned xb_add(unsigned* p, unsigned v) { return __hip_atomic_fetch_add(p, v, __ATOMIC_RELAXED, __HIP_MEMORY_SCOPE_AGENT); }
__device__ __forceinline__ unsigned xb_xcc_id() { return (unsigned)__builtin_amdgcn_s_getreg((3 << 11) | 20) & 0xFu; }
#define XB_SPIN(cond, bar) do { unsigned _sp = 0; while (cond) { __builtin_amdgcn_s_sleep(10); \
    if ((++_sp & 255u) == 0u) { if (xb_ld(&(bar)[XB_TMO])) break; if (_sp > XB_SPIN_CAP) { atomicAdd(&(bar)[XB_TMO], 1u); break; } } } } while (0)

struct XcdBarrier {
    unsigned* bar; unsigned x;
    volatile LAS unsigned* st;
};

__device__ __forceinline__ XcdBarrier xcd_barrier_post(unsigned* bar, volatile LAS unsigned* st) {
    XcdBarrier b; b.bar = bar; b.x = xb_xcc_id(); b.st = st;
    if (threadIdx.x == 0) (void)xb_add(&bar[XB_XCNT(b.x)], 1u);
    return b;
}
__device__ __forceinline__ void xcd_barrier_complete(unsigned* bar, unsigned x, unsigned& nloc, unsigned& nx) {
    const unsigned G = gridDim.x * gridDim.y * gridDim.z;
    unsigned sum, cnt, mine, sp = 0u;
    for (;;) {
        sum = 0u; cnt = 0u; mine = 0u;
#pragma unroll
        for (unsigned j = 0; j < 16; ++j) { const unsigned c = xb_ld(&bar[XB_XCNT(j)]); sum += c; cnt += (c > 0u) ? 1u : 0u; mine = (j == x) ? c : mine; }
        if (sum == G) break;
        __builtin_amdgcn_s_sleep(1);
        if ((++sp & 255u) == 0u) { if (xb_ld(&bar[XB_TMO])) break; if (sp > XB_SPIN_CAP) { atomicAdd(&bar[XB_TMO], 1u); break; } }
    }
    nloc = mine > 0u ? mine : 1u; nx = cnt > 0u ? cnt : 1u;
}

__device__ __forceinline__ void xcd_barrier(const XcdBarrier& b) {
    asm volatile("s_waitcnt vmcnt(0)" ::: "memory");
    __syncthreads();
    if (threadIdx.x == 0) {
        unsigned* bar = sgpr_pin(b.bar); const unsigned bx = sgpr_pin(b.x);
        __builtin_amdgcn_s_waitcnt(0);
        unsigned nloc = b.st[0], nx = b.st[1];
        if (nloc == 0u) { xcd_barrier_complete(bar, bx, nloc, nx); b.st[0] = nloc; b.st[1] = nx; }
        const unsigned old = xb_add(&bar[XB_XSUB(bx)], 1u);
        const unsigned gen = old / nloc;
        if (old + 1u == (gen + 1u) * nloc) {
            __builtin_amdgcn_fence(__ATOMIC_RELEASE, "agent");
            asm volatile("s_waitcnt vmcnt(0)" ::: "memory");
            const unsigned og = xb_add(&bar[XB_TOP], 1u);
            const unsigned tg = og / nx;
            if (og + 1u == (tg + 1u) * nx) xb_add(&bar[XB_TOPGEN], 1u);
            else XB_SPIN(xb_ld(&bar[XB_TOPGEN]) == tg, bar);
            __builtin_amdgcn_fence(__ATOMIC_ACQUIRE, "agent");
            xb_add(&bar[XB_XGEN(bx)], 1u);
            asm volatile("s_waitcnt vmcnt(0)" ::: "memory");
        } else {
            XB_SPIN(xb_ld(&bar[XB_XGEN(bx)]) == gen, bar);
            __builtin_amdgcn_fence(__ATOMIC_ACQUIRE, "agent");
            asm volatile("s_waitcnt vmcnt(0)" ::: "memory");
        }
    }
    __syncthreads();
}

struct FSeg { const bf16_t* K; const bf16_t* V; int pk, pv, nt, pos0, masked; };

template <int DV, bool HASMASK>
DI void flash_tile(const LAS unsigned char* buf, const LAS unsigned char* qlds, f32x16 (&o)[DV / 32], float& m, float& l, int k0, int msk, int qpos, float sc2, int l31, int hi) {
    constexpr int KP = 72, VPD = 40, KBYTES = 64 * KP * 2;
    const LAS bf16_t* KT = (const LAS bf16_t*)buf;
    const LAS unsigned* VT = (const LAS unsigned*)(buf + KBYTES);
    f32x16 s0, s1;
#pragma unroll
    for (int r = 0; r < 16; ++r) { s0[r] = 0.f; s1[r] = 0.f; }
#pragma unroll
    for (int ks = 0; ks < 4; ++ks) {
        const bf16x8 a0 = *(const LAS bf16x8*)(KT + l31 * KP + ks * 16 + hi * 8);
        const bf16x8 a1 = *(const LAS bf16x8*)(KT + (32 + l31) * KP + ks * 16 + hi * 8);
        const bf16x8 qk = *(const LAS bf16x8*)(qlds + ks * 1024);
        s0 = MFMA32(a0, qk, s0); s1 = MFMA32(a1, qk, s1);
    }
    float rm = -3.0e38f;
#pragma unroll
    for (int r = 0; r < 16; ++r) {
        float v0 = s0[r], v1 = s1[r];
        if (HASMASK) { const int kp = k0 + crow(r, hi); int d0 = qpos - kp; d0 = d0 < 0 ? -d0 : d0; int d1 = qpos - kp - 32; d1 = d1 < 0 ? -d1 : d1;
            v0 = (msk != 0 && d0 > 128) ? -1.0e30f : v0; v1 = (msk != 0 && d1 > 128) ? -1.0e30f : v1; s0[r] = v0; s1[r] = v1; }
        rm = __builtin_fmaxf(__builtin_fmaxf(rm, v0), v1);
    }
    rm *= sc2;
    rm = fmaxf(rm, __shfl_xor(rm, 32));
    if (__any(rm > m + 8.f)) {
        const float mn = fmaxf(m, rm); const float alpha = __builtin_amdgcn_exp2f(m - mn); m = mn; l *= alpha;
#pragma unroll
        for (int db = 0; db < DV / 32; ++db) o[db] *= alpha;
    }
    f32x2_t psv = {0.f, 0.f}; const f32x2_t scv = {sc2, sc2}, nmv = {-m, -m};
#pragma unroll
    for (int r = 0; r < 16; ++r) {
        f32x2_t t = {s0[r], s1[r]}; t = t * scv + nmv;
        t.x = __builtin_amdgcn_exp2f(t.x); t.y = __builtin_amdgcn_exp2f(t.y);
        psv += t; s0[r] = t.x; s1[r] = t.y;
    }
    l += psv.x + psv.y;
    bf16x8 bfr[4];
#pragma unroll
    for (int sp = 0; sp < 2; ++sp) {
        u32x4 w0, w1;
        w0.x = pk2(s0[8 * sp], s0[8 * sp + 1]); w0.y = pk2(s0[8 * sp + 2], s0[8 * sp + 3]); w0.z = pk2(s0[8 * sp + 4], s0[8 * sp + 5]); w0.w = pk2(s0[8 * sp + 6], s0[8 * sp + 7]);
        w1.x = pk2(s1[8 * sp], s1[8 * sp + 1]); w1.y = pk2(s1[8 * sp + 2], s1[8 * sp + 3]); w1.z = pk2(s1[8 * sp + 4], s1[8 * sp + 5]); w1.w = pk2(s1[8 * sp + 6], s1[8 * sp + 7]);
        bfr[sp] = __builtin_bit_cast(bf16x8, w0); bfr[2 + sp] = __builtin_bit_cast(bf16x8, w1);
    }
#pragma unroll
    for (int ks = 0; ks < 4; ++ks) {
#pragma unroll
        for (int db = 0; db < DV / 32; ++db) {
            const int d = db * 32 + l31, swz = 2 * ((d >> 3) & 15), dwc = ks * 8 + 2 * hi;
            const u32x2 lo = *(const LAS u32x2*)(VT + d * VPD + (dwc ^ swz));
            const u32x2 hh = *(const LAS u32x2*)(VT + d * VPD + ((dwc + 4) ^ swz));
            u32x4 av; av.x = lo.x; av.y = lo.y; av.z = hh.x; av.w = hh.y;
            o[db] = MFMA32(__builtin_bit_cast(bf16x8, av), bfr[ks], o[db]);
        }
    }
}

template <int DV, bool HASMASK>
DI void flash_run(LAS unsigned char* lds, const bf16x8 (&qf)[4], f32x16 (&o)[DV / 32], float& m, float& l, const FSeg sA, const FSeg sB, int qpos, int qw0, float sc2) {
    const int tid = tid_opaque(), lane = tid & 63, l31 = lane & 31, hi = lane >> 5;
    constexpr int KP = 72, VPD = 40, KBYTES = 64 * KP * 2, VBYTES = DV * VPD * 4, BUFB = KBYTES + VBYTES;
    constexpr int VE = DV / 16, VW = VE / 2;
    const int ntot = sA.nt + sB.nt;
    const int kkey = tid >> 3, kch = (tid & 7) * 8;
    const int vkp = tid >> 4, vd0 = (tid & 15) * VE;
    u32x4 kreg0, kreg1; unsigned va0[VW], vb0[VW], va1[VW], vb1[VW];
#define FL_LOAD(i, kreg, va, vb) do { const bool sec_ = (i) >= sA.nt; const int tl_ = sec_ ? (i) - sA.nt : (i); \
        const bf16_t* Kb_ = sec_ ? sB.K : sA.K; const bf16_t* Vb_ = sec_ ? sB.V : sA.V; const int pk_ = sec_ ? sB.pk : sA.pk, pv_ = sec_ ? sB.pv : sA.pv; \
        kreg = *(const u32x4*)(Kb_ + (size_t)(tl_ * 64 + kkey) * pk_ + kch); \
        const bf16_t* v0_ = Vb_ + (size_t)(tl_ * 64 + 2 * vkp) * pv_ + vd0; \
        if (DV == 128) { const u32x4 t0_ = *(const u32x4*)v0_; const u32x4 t1_ = *(const u32x4*)(v0_ + pv_); \
            va[0] = t0_.x; va[1] = t0_.y; va[VW - 2] = t0_.z; va[VW - 1] = t0_.w; vb[0] = t1_.x; vb[1] = t1_.y; vb[VW - 2] = t1_.z; vb[VW - 1] = t1_.w; } \
        else { const u32x2 t0_ = *(const u32x2*)v0_; const u32x2 t1_ = *(const u32x2*)(v0_ + pv_); va[0] = t0_.x; va[1] = t0_.y; vb[0] = t1_.x; vb[1] = t1_.y; } } while (0)
#define FL_STORE(buf, kreg, va, vb) do { LAS unsigned char* B_ = lds + (buf) * BUFB; \
        *(LAS u32x4*)((LAS bf16_t*)B_ + kkey * KP + kch) = kreg; \
        LAS unsigned* VT_ = (LAS unsigned*)(B_ + KBYTES); \
        _Pragma("unroll") for (int w_ = 0; w_ < VW; ++w_) { \
            const int d0_ = vd0 + 2 * w_, d1_ = d0_ + 1; \
            VT_[d0_ * VPD + (vkp ^ (2 * ((d0_ >> 3) & 15)))] = (va[w_] & 0xffffu) | (vb[w_] << 16); \
            VT_[d1_ * VPD + (vkp ^ (2 * ((d1_ >> 3) & 15)))] = (va[w_] >> 16) | (vb[w_] & 0xffff0000u); } } while (0)
#define FL_TILE(i, buf) do { const bool sec_ = (i) >= sA.nt; const int tl_ = sec_ ? (i) - sA.nt : (i); \
        const int k0_ = (sec_ ? sB.pos0 : sA.pos0) + tl_ * 64; const int msk_ = sec_ ? sB.masked : sA.masked; \
        if (!msk_ || (k0_ + 63 >= qw0 - 128 && k0_ <= qw0 + 31 + 128)) flash_tile<DV, HASMASK>(lds + (buf) * BUFB, qlds, o, m, l, k0_, msk_, qpos, sc2, l31, hi); } while (0)
    LAS unsigned char* qlds = lds + 4 * BUFB + (tid >> 6) * 4096 + lane * 16;
#pragma unroll
    for (int ks = 0; ks < 4; ++ks) *(LAS bf16x8*)(qlds + ks * 1024) = qf[ks];
    if (ntot > 0) { FL_LOAD(0, kreg0, va0, vb0); }
    if (ntot > 1) { FL_LOAD(1, kreg1, va1, vb1); }
    if (ntot > 0) { FL_STORE(0, kreg0, va0, vb0); }
    if (ntot > 1) { FL_STORE(1, kreg1, va1, vb1); }
    __syncthreads();
    for (int i = 0; i < ntot; i += 2) {
        const int pb = (i & 2);
        if (i + 2 < ntot) FL_LOAD(i + 2, kreg0, va0, vb0);
        if (i + 3 < ntot) FL_LOAD(i + 3, kreg1, va1, vb1);
        FL_TILE(i, pb);
        if (i + 1 < ntot) FL_TILE(i + 1, pb + 1);
        if (i + 2 < ntot) FL_STORE(pb ^ 2, kreg0, va0, vb0);
        if (i + 3 < ntot) FL_STORE((pb ^ 2) + 1, kreg1, va1, vb1);
        __syncthreads();
    }
#undef FL_LOAD
#undef FL_STORE
#undef FL_TILE
}

DI void attnA_phase(const Args& a, LAS unsigned char* lds, int li) {
    const int tid = tid_opaque(), lane = tid & 63, l31 = lane & 31, hi = lane >> 5, wid = tid >> 6, G = gridDim.x;
    unsigned char* ws = a.ws;
    const bf16_t* P = (const bf16_t*)(ws + WS_ACT); const bf16_t* QA = (const bf16_t*)(ws + WS_QA); const bf16_t* KA = (const bf16_t*)(ws + WS_KA);
    const bf16_t* CKA = (const bf16_t*)(ws + WS_CKA); const bf16_t* CVA = (const bf16_t*)(ws + WS_CVA);
    bf16_t* MIX = (bf16_t*)(ws + WS_MIX);
    const float sc2 = 0.125f * 1.4426950408889634f;
    const int bidx = bid_opaque();
    const int ubeg = (G == 256) ? (bidx >= 128 ? bidx - 128 : 512 + bidx) : bidx, uend = (G == 256) ? (bidx >= 128 ? 512 : 640) : 640, ustep = (G == 256) ? 128 : G;
    for (int uu = ubeg; uu < uend; uu += ustep) {
        int head, qrow0, qpos0; FSeg sA, sB;
        if (uu < 512) {
            const int b = uu >> 7, rem = uu & 127; head = rem >> 4; const int qb = rem & 15, kvh = head >> 2;
            const int base = TP + b * 4096; qpos0 = qb * 256; qrow0 = base + qpos0;
            int tlo = qpos0 - 128; if (tlo < 0) tlo = 0; tlo >>= 6; int thi = qpos0 + 384; if (thi > 4096) thi = 4096; thi >>= 6;
            sA.K = KA + (size_t)(base + tlo * 64) * 128 + kvh * 64; sA.V = P + (size_t)(base + tlo * 64) * NPE + 640 + kvh * 64; sA.pk = 128; sA.pv = NPE; sA.nt = thi - tlo; sA.pos0 = tlo * 64; sA.masked = 1;
            sB.K = CKA + (size_t)((b * 2 + li) * 256) * 128 + kvh * 64; sB.V = CVA + (size_t)((b * 2 + li) * 256) * 128 + kvh * 64; sB.pk = 128; sB.pv = 128; sB.nt = 4; sB.pos0 = 0; sB.masked = 0;
        } else {
            const int u2 = uu - 512, b = u2 >> 3; head = u2 & 7; const int kvh = head >> 2;
            qrow0 = b * 256; qpos0 = 0;
            sA.K = KA + (size_t)qrow0 * 128 + kvh * 64; sA.V = P + (size_t)qrow0 * NPE + 640 + kvh * 64; sA.pk = 128; sA.pv = NPE; sA.nt = 4; sA.pos0 = 0; sA.masked = 0;
            sB = sA; sB.nt = 0;
        }
        const int qrow = qrow0 + wid * 32 + l31;
        bf16x8 qf[4];
#pragma unroll
        for (int ks = 0; ks < 4; ++ks) qf[ks] = *(const bf16x8*)(QA + (size_t)qrow * 512 + head * 64 + ks * 16 + hi * 8);
        f32x16 o[2];
#pragma unroll
        for (int r = 0; r < 16; ++r) { o[0][r] = 0.f; o[1][r] = 0.f; }
        float m = a.in[20][li * 8 + head] * 1.4426950408889634f, l = hi == 0 ? 1.f : 0.f;
        flash_run<64, true>(lds, qf, o, m, l, sA, sB, qpos0 + wid * 32 + l31, qpos0 + wid * 32, sc2);
        l += __shfl_xor(l, 32);
        const float inv = 1.f / l;
        {
            constexpr int SP = 72; LAS bf16_t* stg = (LAS bf16_t*)(lds + 2 * (9216 + 64 * 40 * 4)) + wid * (32 * SP);
#pragma unroll
            for (int db = 0; db < 2; ++db)
#pragma unroll
                for (int g4 = 0; g4 < 4; ++g4) {
                    u32x2 w; w.x = pk2(o[db][4 * g4] * inv, o[db][4 * g4 + 1] * inv); w.y = pk2(o[db][4 * g4 + 2] * inv, o[db][4 * g4 + 3] * inv);
                    *(LAS u32x2*)(stg + l31 * SP + db * 32 + 8 * g4 + 4 * hi) = w;
                }
            WAVE_LDS_SYNC();
            bf16_t* obase = MIX + (size_t)(qrow0 + wid * 32) * DM + head * 64;
#pragma unroll
            for (int i = 0; i < 4; ++i) { const int row = (lane >> 3) + 8 * i, ch = (lane & 7) * 8; *(u32x4*)(obase + (size_t)row * DM + ch) = *(const LAS u32x4*)(stg + row * SP + ch); }
            WAVE_LDS_SYNC();
        }
    }
}

DI void attnC_phase(const Args& a, LAS unsigned char* lds, int li, int layer) {
    const int tid = tid_opaque(), lane = tid & 63, l31 = lane & 31, hi = lane >> 5, wid = tid >> 6, G = gridDim.x;
    unsigned char* ws = a.ws;
    const bf16_t* P = (const bf16_t*)(ws + WS_ACT); const bf16_t* QC = (const bf16_t*)(ws + WS_QC); const bf16_t* KC = (const bf16_t*)(ws + WS_KC);
    const bf16_t* CKC = (const bf16_t*)(ws + WS_CKC); const bf16_t* CVC = (const bf16_t*)(ws + WS_CVC);
    bf16_t* MIX = (bf16_t*)(ws + WS_MIX);
    const float sc2 = 0.125f * 1.4426950408889634f;
    const float lam_init = 0.8f - 0.6f * expf(-0.3f * (float)sgpr_pin(layer));
    float lam;
    { const float* lv = a.in[26] + li * 256; float d0 = 0.f, d1 = 0.f; for (int e = 0; e < 64; ++e) { d0 += lv[e] * lv[64 + e]; d1 += lv[128 + e] * lv[192 + e]; } lam = expf(d0) - expf(d1) + lam_init; }
    const float* subln = a.in[27] + li * 128;
    for (int uu = bid_opaque(); uu < 320; uu += G) {
        int h, qrow0, krow0, ntl; const bf16_t* ck = nullptr; const bf16_t* cv = nullptr; int ntc = 0;
        if (uu < 256) { const int b = uu >> 6; h = (uu >> 4) & 3; const int qb = uu & 15; krow0 = TP + b * 4096; qrow0 = krow0 + qb * 256; ntl = 64; ck = CKC + (size_t)((b * 2 + li) * 256) * 512 + h * 128; cv = CVC + (size_t)((b * 2 + li) * 256) * 512 + h * 128; ntc = 4; }
        else { const int u2 = uu - 256, b = u2 >> 2; h = u2 & 3; krow0 = b * 256; qrow0 = krow0; ntl = 4; ck = CKC; cv = CVC; ntc = 0; }
        const int qrow = qrow0 + wid * 32 + l31;
        f32x16 o[4];
        u32x4* const o0g = (u32x4*)(ws + WS_O0) + ((size_t)bid_opaque() * NTHREADS + tid) * 8;
#pragma unroll 1
        for (int mp = 0; mp < 2; ++mp) {
            FSeg sA, sB;
            sA.K = KC + (size_t)krow0 * 512 + h * 128 + mp * 64; sA.V = P + (size_t)krow0 * NPO + 1024 + h * 128; sA.pk = 512; sA.pv = NPO; sA.nt = ntl; sA.pos0 = 0; sA.masked = 0;
            sB.K = ck + mp * 64; sB.V = cv; sB.pk = 512; sB.pv = 512; sB.nt = ntc; sB.pos0 = 0; sB.masked = 0;
            bf16x8 qf[4];
#pragma unroll
            for (int ks = 0; ks < 4; ++ks) qf[ks] = *(const bf16x8*)(QC + (size_t)qrow * 512 + h * 128 + mp * 64 + ks * 16 + hi * 8);
#pragma unroll
            for (int db = 0; db < 4; ++db)
#pragma unroll
                for (int r = 0; r < 16; ++r) o[db][r] = 0.f;
            float m = -1.0e30f, l = 0.f;
            flash_run<128, false>(lds, qf, o, m, l, sA, sB, 0, 0, sc2);
            l += __shfl_xor(l, 32);
            const float inv = 1.f / l;
            if (mp == 0) {
#pragma unroll
                for (int db = 0; db < 4; ++db)
#pragma unroll
                    for (int h2 = 0; h2 < 2; ++h2) { u32x4 w; w.x = pk2(o[db][8 * h2] * inv, o[db][8 * h2 + 1] * inv); w.y = pk2(o[db][8 * h2 + 2] * inv, o[db][8 * h2 + 3] * inv); w.z = pk2(o[db][8 * h2 + 4] * inv, o[db][8 * h2 + 5] * inv); w.w = pk2(o[db][8 * h2 + 6] * inv, o[db][8 * h2 + 7] * inv); o0g[db * 2 + h2] = w; }
            } else {
                const float li2 = lam * inv;
#pragma unroll
                for (int db = 0; db < 4; ++db)
#pragma unroll
                    for (int h2 = 0; h2 < 2; ++h2) { const u32x4 w = o0g[db * 2 + h2];
                        o[db][8 * h2 + 0] = bflo(w.x) - o[db][8 * h2 + 0] * li2; o[db][8 * h2 + 1] = bfhi(w.x) - o[db][8 * h2 + 1] * li2; o[db][8 * h2 + 2] = bflo(w.y) - o[db][8 * h2 + 2] * li2; o[db][8 * h2 + 3] = bfhi(w.y) - o[db][8 * h2 + 3] * li2;
                        o[db][8 * h2 + 4] = bflo(w.z) - o[db][8 * h2 + 4] * li2; o[db][8 * h2 + 5] = bfhi(w.z) - o[db][8 * h2 + 5] * li2; o[db][8 * h2 + 6] = bflo(w.w) - o[db][8 * h2 + 6] * li2; o[db][8 * h2 + 7] = bfhi(w.w) - o[db][8 * h2 + 7] * li2; }
            }
        }
        float ss = 0.f;
#pragma unroll
        for (int db = 0; db < 4; ++db)
#pragma unroll
            for (int r = 0; r < 16; ++r) ss += o[db][r] * o[db][r];
        ss += __shfl_xor(ss, 32);
        const float rinv = rsqrtf(ss * (1.f / 128.f) + EPS) * (1.f - lam_init);
        {
            constexpr int SP = 72; LAS bf16_t* stg = (LAS bf16_t*)(lds + 2 * (9216 + 128 * 40 * 4)) + wid * (32 * SP);
            bf16_t* obase = MIX + (size_t)(qrow0 + wid * 32) * DM + h * 128;
#pragma unroll
            for (int hh = 0; hh < 2; ++hh) {
#pragma unroll
                for (int dq = 0; dq < 2; ++dq)
#pragma unroll
                    for (int g4 = 0; g4 < 4; ++g4) {
                        const int db = 2 * hh + dq, d = db * 32 + 8 * g4 + 4 * hi; const f32x4 gs = *(const f32x4*)(subln + d);
                        u32x2 w; w.x = pk2(o[db][4 * g4] * rinv * gs[0], o[db][4 * g4 + 1] * rinv * gs[1]); w.y = pk2(o[db][4 * g4 + 2] * rinv * gs[2], o[db][4 * g4 + 3] * rinv * gs[3]);
                        *(LAS u32x2*)(stg + l31 * SP + dq * 32 + 8 * g4 + 4 * hi) = w;
                    }
                WAVE_LDS_SYNC();
#pragma unroll
                for (int i = 0; i < 4; ++i) { const int row = (lane >> 3) + 8 * i, ch = (lane & 7) * 8; *(u32x4*)(obase + (size_t)row * DM + hh * 64 + ch) = *(const LAS u32x4*)(stg + row * SP + ch); }
                WAVE_LDS_SYNC();
            }
        }
    }
}


constexpr int ML_PT = 136, ML_PD = 68;
constexpr int ML_Q = 0, ML_K = 34816, ML_V = 69632, ML_X = 104448, ML_ARR = 139264;
DI int ml_row0(int u) { return u < 128 ? (u >> 3) * 256 + (u & 1) * 128 : TP + ((u - 128) >> 7) * 4096 + ((u - 128) & 31) * 128; }
DI int ml_head(int u) { return u < 128 ? (u >> 1) & 3 : ((u - 128) >> 5) & 3; }
DI int ml_swz(int row) { return 4 * ((row >> 3) & 7); }
DI void ml_gates(LAS float* AR, const float* gates, const float* bg, int row0, int h, int tid) {
    LAS float* IG = AR; LAS float* LF = AR + 256; LAS float* BC = AR + 512; LAS float* PM = AR + 768;
    if (tid < 256) {
        const int dir = tid >> 7, s = tid & 127;
        const float ig = gates[(size_t)(row0 + s) * 16 + dir * 8 + h] + bg[dir * 8 + h];
        const float fg = gates[(size_t)(row0 + s) * 16 + dir * 8 + 4 + h] + bg[dir * 8 + 4 + h];
        IG[tid] = ig; LF[tid] = fminf(fg, 0.f) - log1pf(__expf(-fabsf(fg)));
    }
    __syncthreads();
    if (tid < 128) {
        const int dir = tid >> 6, lane = tid & 63, k0 = 2 * lane, k1 = k0 + 1;
        const int i0 = dir * 128 + (dir == 0 ? k0 : 127 - k0), i1 = dir * 128 + (dir == 0 ? k1 : 127 - k1);
        const float x0 = LF[i0], x1 = LF[i1], s1 = x0 + x1;
        float incl = s1;
#pragma unroll
        for (int o = 1; o < 64; o <<= 1) { const float t = __shfl_up(incl, o); if (lane >= o) incl += t; }
        const float c0 = incl - s1 + x0, c1 = c0 + x1;
        BC[i0] = c0; BC[i1] = c1;
        const float e0 = IG[i0] - c0, e1 = IG[i1] - c1, m1 = fmaxf(e0, e1);
        float im = m1;
#pragma unroll
        for (int o = 1; o < 64; o <<= 1) { const float t = __shfl_up(im, o); if (lane >= o) im = fmaxf(im, t); }
        float ex = __shfl_up(im, 1); if (lane == 0) ex = -3.0e38f;
        PM[i0] = fmaxf(ex, e0); PM[i1] = fmaxf(ex, m1);
    }
    __syncthreads();
}
DI void ml_load_tile(LAS bf16_t* dst, const bf16_t* src, int pitch, int tid) {
#pragma unroll
    for (int i = 0; i < 4; ++i) { const int grp = tid + 512 * i, s = grp >> 4, c8 = (grp & 15) * 8; *(LAS u32x4*)(dst + s * ML_PT + c8) = *(const u32x4*)(src + (size_t)s * pitch + c8); }
}
DI void ml_store_pair_t(LAS unsigned* dstw, int sp, int c8, const u32x4 r0, const u32x4 r1) {
    const int swz = ml_swz(c8);
    LAS unsigned* p = dstw + c8 * ML_PD + (sp ^ swz);
    p[0 * ML_PD] = (r0.x & 0xffffu) | (r1.x << 16); p[1 * ML_PD] = (r0.x >> 16) | (r1.x & 0xffff0000u);
    p[2 * ML_PD] = (r0.y & 0xffffu) | (r1.y << 16); p[3 * ML_PD] = (r0.y >> 16) | (r1.y & 0xffff0000u);
    p[4 * ML_PD] = (r0.z & 0xffffu) | (r1.z << 16); p[5 * ML_PD] = (r0.z >> 16) | (r1.z & 0xffff0000u);
    p[6 * ML_PD] = (r0.w & 0xffffu) | (r1.w << 16); p[7 * ML_PD] = (r0.w >> 16) | (r1.w & 0xffff0000u);
}
DI void ml_load_tile_t(LAS bf16_t* dst, const bf16_t* src, int pitch, int tid) {
#pragma unroll
    for (int x = 0; x < 2; ++x) {
        const int sp = (tid >> 4) + 32 * x, c8 = (tid & 15) * 8;
        const u32x4 r0 = *(const u32x4*)(src + (size_t)(2 * sp) * pitch + c8), r1 = *(const u32x4*)(src + (size_t)(2 * sp + 1) * pitch + c8);
        ml_store_pair_t((LAS unsigned*)dst, sp, c8, r0, r1);
    }
}
DI bf16x8 ml_frag_t(const LAS bf16_t* tile, int row, int k0) { return *(const LAS bf16x8*)((const LAS unsigned*)tile + row * ML_PD + ((k0 >> 1) ^ ml_swz(row))); }

DI void ml_phase1(const Args& a, LAS unsigned char* lds, int li, int ustart) {
    const int G = gridDim.x;
    unsigned char* ws = a.ws;
    const bf16_t* P = (const bf16_t*)(ws + WS_ACT); const float* GT = (const float*)(ws + WS_GATES);
    float* LB = (float*)(ws + WS_LB); float* NL = (float*)(ws + WS_NL); float* SCAL = (float*)(ws + WS_SCAL);
    LAS bf16_t* KL = (LAS bf16_t*)(lds + ML_K); LAS bf16_t* VT = (LAS bf16_t*)(lds + ML_V); LAS bf16_t* XT = (LAS bf16_t*)(lds + ML_X); LAS float* AR = (LAS float*)(lds + ML_ARR);
    LAS float* IG = AR; LAS float* BC = AR + 512; LAS float* PM = AR + 768; LAS float* WSV = AR + 1024;
    const float* bg = a.in[22] + li * 16;
    for (int u = (bid_opaque() + G - ustart % G) % G; u < NUNIT; u += G) {
        const int tid = tid_opaque(), lane = tid & 63, l31 = lane & 31, hi = lane >> 5, wid = tid >> 6;
        const int ti = wid >> 1, tj0 = (wid & 1) * 2;
        const int row0 = ml_row0(u), h = ml_head(u);
        ml_load_tile(KL, P + (size_t)row0 * NPO + 2048 + h * 128, NPO, tid);
        ml_load_tile_t(VT, P + (size_t)row0 * NPO + 2560 + h * 128, NPO, tid);
        ml_gates(AR, GT, bg, row0, h, tid);
#pragma unroll 1
        for (int dir = 0; dir < 2; ++dir) {
            const float emax = dir == 0 ? PM[127] : PM[128];
            const float bend = dir == 0 ? BC[127] : BC[128];
            if (tid < 128) WSV[tid] = __expf(IG[dir * 128 + tid] - BC[dir * 128 + tid] - emax);
            __syncthreads();
#pragma unroll
            for (int x = 0; x < 2; ++x) {
                const int sp = (tid >> 4) + 32 * x, c8 = (tid & 15) * 8; const float w0 = WSV[2 * sp], w1 = WSV[2 * sp + 1];
                const u32x4 q0 = *(const LAS u32x4*)(KL + (2 * sp) * ML_PT + c8), q1 = *(const LAS u32x4*)(KL + (2 * sp + 1) * ML_PT + c8);
                u32x4 r0, r1;
                r0.x = pk2(bflo(q0.x) * w0, bfhi(q0.x) * w0); r0.y = pk2(bflo(q0.y) * w0, bfhi(q0.y) * w0); r0.z = pk2(bflo(q0.z) * w0, bfhi(q0.z) * w0); r0.w = pk2(bflo(q0.w) * w0, bfhi(q0.w) * w0);
                r1.x = pk2(bflo(q1.x) * w1, bfhi(q1.x) * w1); r1.y = pk2(bflo(q1.y) * w1, bfhi(q1.y) * w1); r1.z = pk2(bflo(q1.z) * w1, bfhi(q1.z) * w1); r1.w = pk2(bflo(q1.w) * w1, bfhi(q1.w) * w1);
                ml_store_pair_t((LAS unsigned*)XT, sp, c8, r0, r1);
            }
            __syncthreads();
            f32x16 acc[2];
#pragma unroll
            for (int r = 0; r < 16; ++r) { acc[0][r] = 0.f; acc[1][r] = 0.f; }
#pragma unroll 2
            for (int ks = 0; ks < 8; ++ks) {
                const bf16x8 av = ml_frag_t(VT, 32 * ti + l31, ks * 16 + 8 * hi);
#pragma unroll
                for (int jj = 0; jj < 2; ++jj) { const bf16x8 bv = ml_frag_t(XT, 32 * (tj0 + jj) + l31, ks * 16 + 8 * hi); acc[jj] = MFMA32(av, bv, acc[jj]); }
            }
            float* Lo = LB + (size_t)(u * 2 + dir) * 16384;
#pragma unroll
            for (int jj = 0; jj < 2; ++jj)
#pragma unroll
                for (int r = 0; r < 16; ++r) Lo[(32 * ti + crow(r, hi)) * 128 + 32 * (tj0 + jj) + l31] = acc[jj][r];
            {
                const int d = tid >> 2, part = tid & 3; float s = 0.f;
#pragma unroll
                for (int q = 0; q < 4; ++q) { const bf16x8 f = ml_frag_t(XT, d, part * 32 + q * 8);
#pragma unroll
                    for (int e = 0; e < 8; ++e) s += bf2f((bf16_t)f[e]); }
                s += __shfl_xor(s, 1); s += __shfl_xor(s, 2);
                if (part == 0) NL[(size_t)(u * 2 + dir) * 128 + d] = s;
            }
            if (tid == 0) { SCAL[u * 2 + dir] = bend; SCAL[2 * NUNIT + u * 2 + dir] = bend + emax; }
            __syncthreads();
        }
    }
}
template <int GS>
DI void ml_scan_group(int k0, int nc, int dir, int ubase, bool isn, int en, int e, const float* __restrict__ SCALr, float* SCALw, const float* __restrict__ NL, const float* __restrict__ LB,
                      float* __restrict__ NPREV, bf16_t* __restrict__ CPREV, f32x4& cur, float& m) {
    int udv[GS]; float bev[GS], mlv[GS]; f32x4 locv[GS];
#pragma unroll
    for (int j = 0; j < GS; ++j) {
        const int k = k0 + j, c = dir == 0 ? k : nc - 1 - k; udv[j] = (ubase + c) * 2 + dir;
        bev[j] = SCALr[udv[j]]; mlv[j] = SCALr[2 * NUNIT + udv[j]];
        locv[j] = isn ? *(const f32x4*)(NL + (size_t)udv[j] * 128 + en) : *(const f32x4*)(LB + (size_t)udv[j] * 16384 + e);
    }
#pragma unroll
    for (int j = 0; j < GS; ++j) {
        const int ud = udv[j];
        if (isn) *(f32x4*)(NPREV + (size_t)ud * 128 + en) = cur;
        else { u32x2 w; w.x = pk2(cur[0], cur[1]); w.y = pk2(cur[2], cur[3]); *(u32x2*)(CPREV + (size_t)ud * 16384 + e) = w; }
        if (e == 0) SCALw[4 * NUNIT + ud] = m;
        const float mn = fmaxf(bev[j] + m, mlv[j]);
        cur = cur * __expf(bev[j] + m - mn) + locv[j] * __expf(mlv[j] - mn); m = mn;
    }
}
DI void ml_phase2(const Args& a, int li) {
    unsigned char* ws = a.ws;
    const float* LB = (const float*)(ws + WS_LB); const float* NL = (const float*)(ws + WS_NL); float* SCAL = (float*)(ws + WS_SCAL);
    bf16_t* CPREV = (bf16_t*)(ws + WS_CPREV); float* NPREV = (float*)(ws + WS_NPREV);
    const size_t gt = (size_t)bid_opaque() * NTHREADS + tid_opaque(), NGT = (size_t)gridDim.x * NTHREADS;
    for (size_t it = gt; it < (size_t)160 * 4128; it += NGT) {
        const int seq = (int)(it / 4128), e = (int)(it - (size_t)seq * 4128) * 4;
        const bool isn = e >= 16384; const int en = e - 16384, vv = e >> 7, d0 = e & 127;
        int b, h, dir, nc, ubase; f32x4 cur = {0.f, 0.f, 0.f, 0.f}; float m; const bool smp = seq >= 128;
        if (!smp) { b = seq >> 3; h = (seq >> 1) & 3; dir = seq & 1; nc = 2; ubase = (b * 4 + h) * 2; m = 0.f; }
        else { const int sq = seq - 128; b = sq >> 3; h = (sq >> 1) & 3; dir = sq & 1; nc = 32; ubase = 128 + (b * 4 + h) * 32;
            const size_t sidx = (size_t)((b * 2 + li) * 2 + dir) * 4 + h;
            if (isn) cur = *(const f32x4*)(a.in[8] + sidx * 128 + en);
            else { const float* s0 = a.in[7] + sidx * 16384 + (size_t)d0 * 128 + vv; cur = (f32x4){s0[0], s0[128], s0[256], s0[384]}; }
            m = a.in[9][sidx]; }
        if (smp) {
#pragma unroll 1
            for (int k0 = 0; k0 < 32; k0 += 8) ml_scan_group<8>(k0, nc, dir, ubase, isn, en, e, SCAL, SCAL, NL, LB, NPREV, CPREV, cur, m);
        } else ml_scan_group<2>(0, nc, dir, ubase, isn, en, e, SCAL, SCAL, NL, LB, NPREV, CPREV, cur, m);
        if (!smp) {
            const size_t sidx = (size_t)((b * 2 + li) * 2 + dir) * 4 + h;
            if (isn) *(f32x4*)(a.out + O_ND + sidx * 128 + en) = cur;
            else { float* o0 = a.out + O_CD + sidx * 16384 + (size_t)d0 * 128 + vv; o0[0] = cur[0]; o0[128] = cur[1]; o0[256] = cur[2]; o0[384] = cur[3]; }
            if (e == 0) a.out[O_MD + sidx] = m;
        }
    }
}
DI void ml_phase3(const Args& a, LAS unsigned char* lds, int li) {
    const int G = gridDim.x;
    unsigned char* ws = a.ws;
    const bf16_t* P = (const bf16_t*)(ws + WS_ACT); const float* GT = (const float*)(ws + WS_GATES);
    const bf16_t* CPREV = (const bf16_t*)(ws + WS_CPREV); const float* NPREV = (const float*)(ws + WS_NPREV); const float* SCAL = (const float*)(ws + WS_SCAL);
    bf16_t* MIX = (bf16_t*)(ws + WS_MIX);
    LAS bf16_t* QL = (LAS bf16_t*)(lds + ML_Q); LAS bf16_t* KL = (LAS bf16_t*)(lds + ML_K); LAS bf16_t* VT = (LAS bf16_t*)(lds + ML_V); LAS bf16_t* XL = (LAS bf16_t*)(lds + ML_X);
    LAS float* AR = (LAS float*)(lds + ML_ARR);
    LAS float* IG = AR; LAS float* BC = AR + 512; LAS float* PM = AR + 768; LAS float* MT = AR + 1024; LAS float* DEN = AR + 1152; LAS float* QN = AR + 1280; LAS float* SS = AR + 1408; LAS float* NP = AR + 1536;
    const float* bg = a.in[22] + li * 16; const float* onorm = a.in[28] + li * 128;
    for (int u = bid_opaque(); u < NUNIT; u += G) {
        const int tid = tid_opaque(), lane = tid & 63, l31 = lane & 31, hi = lane >> 5, wid = tid >> 6;
        const int ti = wid >> 1, tj0 = (wid & 1) * 2;
        const int row0 = ml_row0(u), h = ml_head(u);
        ml_load_tile(QL, P + (size_t)row0 * NPO + 1536 + h * 128, NPO, tid);
        ml_load_tile(KL, P + (size_t)row0 * NPO + 2048 + h * 128, NPO, tid);
        ml_load_tile_t(VT, P + (size_t)row0 * NPO + 2560 + h * 128, NPO, tid);
        ml_gates(AR, GT, bg, row0, h, tid);
        f32x16 S[2], hs[2];
#pragma unroll
        for (int r = 0; r < 16; ++r) { S[0][r] = 0.f; S[1][r] = 0.f; hs[0][r] = 0.f; hs[1][r] = 0.f; }
#pragma unroll 2
        for (int ks = 0; ks < 8; ++ks) {
            const bf16x8 av = *(const LAS bf16x8*)(QL + (32 * ti + l31) * ML_PT + ks * 16 + 8 * hi);
#pragma unroll
            for (int jj = 0; jj < 2; ++jj) { const bf16x8 bv = *(const LAS bf16x8*)(KL + (32 * (tj0 + jj) + l31) * ML_PT + ks * 16 + 8 * hi); S[jj] = MFMA32(av, bv, S[jj]); }
        }
        __syncthreads();
#pragma unroll 1
        for (int dir = 0; dir < 2; ++dir) {
            const int ud = u * 2 + dir; const float mprev = SCAL[4 * NUNIT + ud];
            ml_load_tile(XL, CPREV + (size_t)ud * 16384, 128, tid);
            if (tid < 128) { NP[tid] = NPREV[(size_t)ud * 128 + tid]; MT[tid] = BC[dir * 128 + tid] + fmaxf(mprev, PM[dir * 128 + tid]); }
            __syncthreads();
            const int sg = dir == 0 ? 1 : -1, dts = sg * (32 * ti + 4 * hi - 32 * tj0 - l31);
#pragma unroll
            for (int jj = 0; jj < 2; ++jj) {
                const int s = 32 * (tj0 + jj) + l31; const float es = IG[dir * 128 + s] - BC[dir * 128 + s];
#pragma unroll
                for (int r = 0; r < 16; ++r) {
                    const int t = 32 * ti + crow(r, hi);
                    const bool valid = (dts + sg * (crow(r, 0) - 32 * jj)) >= 0;
                    const float w = valid ? __expf(BC[dir * 128 + t] - MT[t] + es) : 0.f;
                    KL[t * ML_PT + s] = f2bf(S[jj][r] * w);
                }
            }
            __syncthreads();
            {
                const int t = tid >> 2, part = tid & 3; float sd = 0.f, sq = 0.f;
#pragma unroll
                for (int q = 0; q < 4; ++q) {
                    const bf16x8 f = *(const LAS bf16x8*)(KL + t * ML_PT + part * 32 + q * 8);
                    const bf16x8 g = *(const LAS bf16x8*)(QL + t * ML_PT + part * 32 + q * 8);
#pragma unroll
                    for (int e = 0; e < 8; ++e) { sd += bf2f((bf16_t)f[e]); sq += bf2f((bf16_t)g[e]) * NP[part * 32 + q * 8 + e]; }
                }
                sd += __shfl_xor(sd, 1); sd += __shfl_xor(sd, 2); sq += __shfl_xor(sq, 1); sq += __shfl_xor(sq, 2);
                if (part == 0) { DEN[t] = sd; QN[t] = sq; }
            }
            f32x16 acc[2];
#pragma unroll
            for (int r = 0; r < 16; ++r) { acc[0][r] = 0.f; acc[1][r] = 0.f; }
            const float wq = __expf(BC[dir * 128 + 32 * ti + l31] + mprev - MT[32 * ti + l31]);
#pragma unroll 2
            for (int ks = 0; ks < 8; ++ks) {
                const bf16x8 a1 = *(const LAS bf16x8*)(KL + (32 * ti + l31) * ML_PT + ks * 16 + 8 * hi);
                const u32x4 qraw = *(const LAS u32x4*)(QL + (32 * ti + l31) * ML_PT + ks * 16 + 8 * hi);
                u32x4 qs; qs.x = pk2(bflo(qraw.x) * wq, bfhi(qraw.x) * wq); qs.y = pk2(bflo(qraw.y) * wq, bfhi(qraw.y) * wq); qs.z = pk2(bflo(qraw.z) * wq, bfhi(qraw.z) * wq); qs.w = pk2(bflo(qraw.w) * wq, bfhi(qraw.w) * wq);
                const bf16x8 a2 = __builtin_bit_cast(bf16x8, qs);
#pragma unroll
                for (int jj = 0; jj < 2; ++jj) {
                    const bf16x8 bv = ml_frag_t(VT, 32 * (tj0 + jj) + l31, ks * 16 + 8 * hi);
                    acc[jj] = MFMA32(a1, bv, acc[jj]);
                    const bf16x8 bc = *(const LAS bf16x8*)(XL + (32 * (tj0 + jj) + l31) * ML_PT + ks * 16 + 8 * hi);
                    acc[jj] = MFMA32(a2, bc, acc[jj]);
                }
            }
            __syncthreads();
#pragma unroll
            for (int r = 0; r < 16; ++r) {
                const int t = 32 * ti + crow(r, hi);
                const float wi = __expf(BC[dir * 128 + t] + mprev - MT[t]);
                const float den = DEN[t] + wi * QN[t];
                const float dn = fmaxf(fabsf(den), __expf(-MT[t])), rdn = 1.f / dn;
                hs[0][r] += acc[0][r] * rdn; hs[1][r] += acc[1][r] * rdn;
            }
            __syncthreads();
        }
        if (tid < 128) SS[tid] = 0.f;
        __syncthreads();
#pragma unroll
        for (int r = 0; r < 16; ++r) {
            float v = hs[0][r] * hs[0][r] + hs[1][r] * hs[1][r];
            v += __shfl_xor(v, 1); v += __shfl_xor(v, 2); v += __shfl_xor(v, 4); v += __shfl_xor(v, 8); v += __shfl_xor(v, 16);
            if (l31 == 0) atomicAdd((float*)&SS[32 * ti + crow(r, hi)], v);
        }
        __syncthreads();
#pragma unroll
        for (int r = 0; r < 16; ++r) {
            const int t = 32 * ti + crow(r, hi); const float rinv = rsqrtf(SS[t] * (1.f / 128.f) + EPS);
#pragma unroll
            for (int jj = 0; jj < 2; ++jj) { const int v = 32 * (tj0 + jj) + l31; XL[t * ML_PT + v] = f2bf(hs[jj][r] * rinv * onorm[v]); }
        }
        __syncthreads();
#pragma unroll 1
        for (int i = 0; i < 4; ++i) {
            const int grp = tid + 512 * i, t = grp >> 4, c8 = (grp & 15) * 8;
            const u32x4 hv = *(const LAS u32x4*)(XL + t * ML_PT + c8);
            const u32x4 od = *(const u32x4*)(P + (size_t)(row0 + t) * NPO + 3072 + h * 128 + c8);
            u32x4 w;
            w.x = pk2(bflo(hv.x) * sigmoidf_(bflo(od.x)), bfhi(hv.x) * sigmoidf_(bfhi(od.x))); w.y = pk2(bflo(hv.y) * sigmoidf_(bflo(od.y)), bfhi(hv.y) * sigmoidf_(bfhi(od.y)));
            w.z = pk2(bflo(hv.z) * sigmoidf_(bflo(od.z)), bfhi(hv.z) * sigmoidf_(bfhi(od.z))); w.w = pk2(bflo(hv.w) * sigmoidf_(bflo(od.w)), bfhi(hv.w) * sigmoidf_(bfhi(od.w)));
            *(u32x4*)(MIX + (size_t)(row0 + t) * DM + 512 + h * 128 + c8) = w;
        }
        __syncthreads();
    }
}

constexpr size_t WS_CTL = WS_END, CTL_BYTES = 65536, WS_TOTAL = WS_END + 60 * MiB;
constexpr int MISC_OFF = LDS_BYTES - 64;
#ifndef PH_DUP
#define PH_DUP 0
#endif
#define REP(bit) _Pragma("unroll 1") for (int rep_ = 0; rep_ < (((PH_DUP) & (bit)) ? 2 : 1); ++rep_)
#ifndef PH_MASK
#define PH_MASK 0xFFFF
#endif
__global__ void __launch_bounds__(NTHREADS, 2) mega_fwd(Args a) {
    extern __shared__ __attribute__((aligned(16))) unsigned char lds_raw[];
    LAS unsigned char* lds = (LAS unsigned char*)lds_raw;
    cg::grid_group grid = cg::this_grid();
    const int G = gridDim.x;
#define bid bid_opaque()
    unsigned char* ws = a.ws;
    float* X = a.out;
    const float* MOD = (const float*)(ws + WS_MOD);

    if (threadIdx.x < 16) ((LAS unsigned*)(lds + MISC_OFF))[threadIdx.x] = 0u;
    __syncthreads();
    const XcdBarrier xbar = xcd_barrier_post((unsigned*)(ws + WS_CTL), (volatile LAS unsigned*)(lds + MISC_OFF));
    REP(1) if (PH_MASK & 1) prepass(a, lds);
    grid.sync();
#define GRID_BAR() xcd_barrier(xbar)
#pragma unroll 1
    for (int l = 0; l < 4; ++l) {
        const int li = l >> 1; const bool odd = (l & 1) != 0;
        const float* modl = MOD + (size_t)l * 5 * NMODW;
#pragma unroll 1
        for (int sub = 0; sub < 3; ++sub) {
            const bool first = (l == 0 && sub == 0);
            REP(2) if (PH_MASK & 2) norm_phase(a.in[0], a.in[1], first ? nullptr : (const bf16_t*)(ws + WS_XB), (bf16_t*)(ws + WS_HN), a.in[13] + (size_t)(l * 3 + sub) * DM, modl, sub);
            GRID_BAR();
            if (sub != 1) {
                const int jj = sub >> 1;
                const pg8::Gemm g{(const bf16_t*)(ws + WS_HN), (const bf16_t*)(ws + WS_WFI) + (size_t)(l * 2 + jj) * 2 * DFF * DM, TT, 2 * DFF, DM};
                pg8::StaticOrder S; S.init(TT, 2 * DFF, G, bid);
                const EpiSwiglu E{(bf16_t*)(ws + WS_ACT)};
                REP(4) if (PH_MASK & 4) pg8::gemm_phase<EpiSwiglu, pg8::StaticOrder, true, true>(lds, g, S, E);
                GRID_BAR();
            } else {
                {
                    const bf16_t* wi = odd ? (const bf16_t*)(ws + WS_WIO) + (size_t)li * NPO * DM : (const bf16_t*)(ws + WS_WIE) + (size_t)li * 1792 * DM;
                    const pg8::Gemm g{(const bf16_t*)(ws + WS_HN), wi, TT, odd ? NPO : NPE, DM};
                    const EpiStore<0> E{(bf16_t*)(ws + WS_ACT), odd ? NPO : NPE, 1.f, (float*)(ws + WS_GATES), 0, 0};
                    pg8::StaticOrder S; S.init(g.M, g.N, G, bid);
                    REP(8) if (PH_MASK & 8) pg8::gemm_phase<EpiStore<0>, pg8::StaticOrder, true, true>(lds, g, S, E);
                }
                if (!odd) {
                    const pg8::Gemm g{(const bf16_t*)(ws + WS_WIE) + (size_t)li * 1792 * DM + (size_t)768 * DM, (const bf16_t*)(ws + WS_HN), 1024, TT, DM};
                    const EpiStore<1> E{(bf16_t*)(ws + WS_PQT), 0, 1.f, nullptr, 0, 0};
                    pg8::StaticOrder S; S.init(g.M, g.N, G, bid);
                    REP(8192) if (PH_MASK & 8192) pg8::gemm_phase<EpiStore<1>, pg8::StaticOrder, true, true>(lds, g, S, E);
                }
                GRID_BAR();
                if (!odd) {
                    REP(16) if (PH_MASK & 16) postproj_even(a, li);
                    GRID_BAR();
                    REP(32) if (PH_MASK & 32) attnA_phase(a, lds, li);
#pragma unroll 1
                    for (int q = 0; q < 2; ++q) {
                        const pg8::Gemm g{(const bf16_t*)(ws + (q ? WS_DP : WS_DS)), (const bf16_t*)(ws + WS_PQF) + (q ? 0 : PQF_S0), q ? 256 : 4096, q ? 8192 : 2048, q ? 2 * HPP : 2 * HPS};
                        const EpiStore<2> E{(bf16_t*)(ws + WS_MIX), 0, q ? 0.005524271728f : 0.001381067932f, nullptr, q ? 0 : TP, q ? 256 : 4096};
                        const SimpleOrder S{q ? 1 : 16, q ? 32 : 8, G, q ? (bid + G - 128 % G) % G : bid, 0};
                        REP(64) if (PH_MASK & 64) pg8::gemm_phase<EpiStore<2>, SimpleOrder, true, true>(lds, g, S, E);
                    }
                    GRID_BAR();
                } else {
                    REP(128) if (PH_MASK & 128) postproj_odd(a, li);
                    GRID_BAR();
                    REP(256) if (PH_MASK & 256) ml_phase1(a, lds, li, 64);
                    REP(512) if (PH_MASK & 512) attnC_phase(a, lds, li, l);
                    GRID_BAR();
                    REP(1024) if (PH_MASK & 1024) ml_phase2(a, li);
                    GRID_BAR();
                    REP(2048) if (PH_MASK & 2048) ml_phase3(a, lds, li);
                    GRID_BAR();
                }
            }
            {
                const bool ffn = sub != 1;
                const bf16_t* wsrc = ffn ? (const bf16_t*)(ws + WS_WFO) + (size_t)(l * 2 + (sub >> 1)) * DM * DFF : (const bf16_t*)(ws + (odd ? WS_WOO : WS_WOE)) + (size_t)li * DM * DM;
                const pg8::Gemm g{(const bf16_t*)(ws + (ffn ? WS_ACT : WS_MIX)), wsrc, TT, DM, ffn ? DFF : DM};

                pg8::StaticOrder S; S.init(TT, DM, G, bid);
                REP(4096) { const int ls = l * 3 + sub;
                    const EpiResid E{(bf16_t*)(ws + WS_XB), X, a.in[0], a.in[1], modl + (ffn ? (3 * sub + 2) : 5) * DM, rep_ ? 0.f : (ffn ? 0.5f : 1.f), ((first && !rep_) ? 1 : 0) | (ls == 11 ? 2 : 0)};
                    if (PH_MASK & 4096) pg8::gemm_phase<EpiResid, pg8::StaticOrder, true, true>(lds, g, S, E); }
            }
            GRID_BAR();
        }
    }
}

extern "C" void kernel_launch(void* const* d_in, const int* in_sizes, int n_in, void* d_out, int out_size, void* d_ws, size_t ws_size, hipStream_t stream) {
    static int grid = 0;
    if (grid == 0) {
        if (n_in != 29 || out_size != 35684608 || ws_size < WS_TOTAL) { fprintf(stderr, "kernel_launch: unexpected shapes (n_in %d out %d ws %zu need %zu)\n", n_in, out_size, ws_size, (size_t)WS_TOTAL); grid = -1; return; }
        int dev = 0, cus = 0, per_cu = 0;
        hipGetDevice(&dev);
        hipDeviceGetAttribute(&cus, hipDeviceAttributeMultiprocessorCount, dev);
        if (hipFuncSetAttribute((const void*)mega_fwd, hipFuncAttributeMaxDynamicSharedMemorySize, LDS_BYTES) != hipSuccess) { fprintf(stderr, "kernel_launch: hipFuncSetAttribute failed\n"); grid = -1; return; }
        if (hipOccupancyMaxActiveBlocksPerMultiprocessor(&per_cu, (const void*)mega_fwd, NTHREADS, LDS_BYTES) != hipSuccess || per_cu < 1) { fprintf(stderr, "kernel_launch: occupancy query failed (%d)\n", per_cu); (void)hipGetLastError(); per_cu = 1; }
        grid = cus * per_cu;
    }
    if (grid < 0) return;
    if (hipMemsetAsync((char*)d_ws + WS_CTL, 0, CTL_BYTES, stream) != hipSuccess) { fprintf(stderr, "kernel_launch: memset failed\n"); return; }
    Args a{};
    for (int i = 0; i < 29; ++i) a.in[i] = (const float*)d_in[i];
    a.out = (float*)d_out; a.ws = (unsigned char*)d_ws;
    void* args[] = {&a};
    hipError_t e = hipLaunchCooperativeKernel((const void*)mega_fwd, dim3(grid), dim3(NTHREADS), args, LDS_BYTES, stream);
    if (e != hipSuccess) fprintf(stderr, "cooperative launch failed: %s (grid %d)\n", hipGetErrorString(e), grid);
}
```

```cpp
#include <hip/hip_runtime.h>
#include <hip/hip_cooperative_groups.h>
#include <cstdio>
#include <cstdint>
namespace cg = cooperative_groups;
__device__ __forceinline__ int tid_opaque() { int t = threadIdx.x; asm volatile("" : "+v"(t)); return t; }
__device__ __forceinline__ int bid_opaque() { int b = blockIdx.x; asm volatile("" : "+s"(b)); return b; }
namespace pg8 {
#define PG8_LAS __attribute__((address_space(3)))
typedef unsigned short bf16_t;
typedef short bf16x8 __attribute__((ext_vector_type(8)));
typedef float f32x4 __attribute__((ext_vector_type(4)));
typedef unsigned u32x4 __attribute__((ext_vector_type(4)));
constexpr int BM = 256, BK = 64, HALF = 128, HTB = HALF * BK * 2  , STAGE_BYTES = 8 * HTB, NXCD = 8, WGM = 4;

__host__ __device__ __forceinline__ int lds_byte(int r, int c) { const int st = (r >> 4) * 2 + (c >> 5), rr = r & 15, cc = c & 31, ob = rr * 64 + cc * 2; return st * 1024 + (ob ^ (((ob >> 9) & 1) << 5)); }
__host__ __device__ __forceinline__ void stage_rc(int b, int& R, int& C) { const int st = b / 1024, sb = b % 1024, swz = sb ^ (((sb >> 9) & 1) << 5); R = (st >> 1) * 16 + swz / 64; C = (st & 1) * 32 + (swz % 64) / 2; }
__host__ __device__ __forceinline__ int perm32(int rho) { const int n = rho >> 4, i = rho & 15; return 8 * (i >> 2) + 4 * n + (i & 3); }

struct Unit { int pm, pn, qm; };
struct Gemm { const bf16_t* A; const bf16_t* Bt; int M, N, K, ld; };

struct StaticOrder {
    int nM, nN, nwg, G, c;
    __host__ __device__ void init(int M, int N, int G_, int c_) { nM = M / BM; nN = N / BM; nwg = nM * nN; G = G_; c = c_; }
    __host__ __device__ bool next(int i, Unit& u) const {
        const long L = (long)i * G + c; if (L >= nwg) return false;
        int wgid = (int)L; { const int q = nwg / NXCD, r = nwg % NXCD, xcd = wgid % NXCD, off = wgid / NXCD; wgid = (xcd < r ? xcd * (q + 1) : r * (q + 1) + (xcd - r) * q) + off; }
        const int nig = WGM * nN, gid = wgid / nig, fm = gid * WGM, gsz = (nM - fm) < WGM ? (nM - fm) : WGM;
        u.pm = fm + ((wgid % nig) % gsz); u.pn = (wgid % nig) / gsz; u.qm = 15; return true;
    }
    __device__ __forceinline__ void a_ready(const Unit&) const {}
    __device__ __forceinline__ void done(const Unit&) const {}
};

__device__ __forceinline__ unsigned cvt_pk_bf16(float lo, float hi) { unsigned r; asm volatile("v_cvt_pk_bf16_f32 %0, %1, %2" : "=v"(r) : "v"(lo), "v"(hi)); return r; }
typedef float f32x2 __attribute__((ext_vector_type(2)));
template <class Epi, class Sched, bool ALIGN_EPI = false, bool SP2 = false>
__device__ __forceinline__ void gemm_phase(PG8_LAS unsigned char* lds, const Gemm g, const Sched& S, const Epi& E) {
    const int tid = tid_opaque(), wid = __builtin_amdgcn_readfirstlane(tid >> 6), lane = tid & 63, wr = wid >> 2, wc = wid & 3, fr = lane & 15, fq = lane >> 4;
    const int K = g.K, nt = K / BK, LD = g.ld ? g.ld : g.K;
    unsigned voffA[2], voffB[2];
#pragma unroll
    for (int i = 0; i < 2; ++i) { int R, C; stage_rc(tid * 16 + i * 8192, R, C); const int Rb = Epi::PERM ? ((R & ~31) + perm32(R & 31)) : R;
        voffA[i] = (unsigned)(R * LD + C) * 2u; voffB[i] = (unsigned)(Rb * LD + C) * 2u; }
    const size_t kstep = (size_t)(BK * 2);
    const size_t hstep = (size_t)HALF * LD * 2;
    const size_t tstep = 2 * hstep;
    const unsigned ldsw = (unsigned)wid * 1024u;
    const int aoff = lds_byte(wr * 64 + fr, fq * 8), boff = lds_byte(wc * 32 + fr, fq * 8);
#define PG8_SA(b, h) (((b) * 2 + (h)) * HTB)
#define PG8_SB(b, h) ((4 + (b) * 2 + (h)) * HTB)
#define PG8_STAGE(bufoff, gbase, voff) do { _Pragma("unroll") for (int _i = 0; _i < 2; ++_i) \
        __builtin_amdgcn_global_load_lds((const unsigned*)((const char*)(gbase) + (voff)[_i]), (PG8_LAS unsigned*)(lds + (bufoff) + ldsw + _i * 8192), 16, 0, 0); } while (0)
#define PG8_LDA(dst, b, h) do { _Pragma("unroll") for (int m = 0; m < 4; ++m) _Pragma("unroll") for (int k = 0; k < 2; ++k) dst[m][k] = *(const PG8_LAS bf16x8*)(lds + PG8_SA(b, h) + aoff + m * 2048 + k * 1024); } while (0)
#define PG8_LDB(dst, b, h) do { _Pragma("unroll") for (int n = 0; n < 2; ++n) _Pragma("unroll") for (int k = 0; k < 2; ++k) dst[n][k] = *(const PG8_LAS bf16x8*)(lds + PG8_SB(b, h) + boff + n * 2048 + k * 1024); } while (0)
#define PG8_MMA(ai, bj, At, Bt) do { if (!(cur.qm & (1 << (2 * (ai) + (bj))))) break; __builtin_amdgcn_s_setprio(1); _Pragma("unroll") for (int m = 0; m < 4; ++m) _Pragma("unroll") for (int n = 0; n < 2; ++n) _Pragma("unroll") for (int k = 0; k < 2; ++k) \
        acc[ai][bj][m][n] = __builtin_amdgcn_mfma_f32_16x16x32_bf16(Bt[n][k], At[m][k], acc[ai][bj][m][n], 0, 0, 0); __builtin_amdgcn_s_setprio(0); } while (0)
#define PG8_WAIT_V(n) asm volatile("s_waitcnt vmcnt(" #n ")" ::: "memory")
#define PG8_WAIT_L(n) asm volatile("s_waitcnt lgkmcnt(" #n ")" ::: "memory")
#define PG8_BAR __builtin_amdgcn_s_barrier()
#define PG8_SCHED __builtin_amdgcn_sched_barrier(0)
    Unit cur, nxt; int ui = 0;
    if (!S.next(0, cur)) return;
    f32x4 acc[2][2][4][2];
#pragma unroll
    for (int a = 0; a < 2; ++a)
#pragma unroll
        for (int b = 0; b < 2; ++b)
#pragma unroll
            for (int m = 0; m < 4; ++m)
#pragma unroll
                for (int n = 0; n < 2; ++n) acc[a][b][m][n] = (f32x4){0.f, 0.f, 0.f, 0.f};
    bf16x8 At[4][2], B0[2][2], B1[2][2];
    const char* cA = (const char*)g.A + (size_t)cur.pm * tstep; const char* cB = (const char*)g.Bt + (size_t)cur.pn * tstep;
    S.a_ready(cur);
    if constexpr (SP2) {
        PG8_STAGE(PG8_SB(0, 0), cB, voffB); PG8_STAGE(PG8_SB(0, 1), cB + hstep, voffB); PG8_STAGE(PG8_SA(0, 0), cA, voffA); PG8_STAGE(PG8_SA(0, 1), cA + hstep, voffA);
        if (wr == 1) PG8_BAR;
        PG8_WAIT_V(2); PG8_BAR;
        PG8_STAGE(PG8_SB(1, 0), cB + kstep, voffB); PG8_STAGE(PG8_SA(1, 0), cA + kstep, voffA); PG8_STAGE(PG8_SB(1, 1), cB + hstep + kstep, voffB);
        PG8_WAIT_V(6); PG8_BAR;
    } else {
        PG8_STAGE(PG8_SB(0, 0), cB, voffB); PG8_STAGE(PG8_SA(0, 0), cA, voffA); PG8_STAGE(PG8_SB(0, 1), cB + hstep, voffB); PG8_STAGE(PG8_SA(0, 1), cA + hstep, voffA);
        if (wr == 1) PG8_BAR;
        PG8_WAIT_V(4); PG8_BAR;
        PG8_STAGE(PG8_SB(1, 0), cB + kstep, voffB); PG8_STAGE(PG8_SA(1, 0), cA + kstep, voffA); PG8_STAGE(PG8_SB(1, 1), cB + hstep + kstep, voffB);
        PG8_WAIT_V(6); PG8_BAR;
    }
    for (;;) {
        const bool has_next = S.next(ui + 1, nxt);
        const char* nA = has_next ? (const char*)g.A + (size_t)nxt.pm * tstep : cA; const char* nB = has_next ? (const char*)g.Bt + (size_t)nxt.pn * tstep : cB;
        for (int t = 0; t < nt; t += 2) {
            const bool last = (t == nt - 2);
            const char* a1 = cA + (size_t)(t + 1) * kstep;
            const char* a2 = last ? nA : cA + (size_t)(t + 2) * kstep; const char* b2 = last ? nB : cB + (size_t)(t + 2) * kstep;
            const char* a3 = a2 + kstep; const char* b3 = b2 + kstep;
            if (last && has_next) S.a_ready(nxt);
            if constexpr (SP2) {
            PG8_LDB(B0, 0, 0); PG8_LDB(B1, 0, 1); PG8_SCHED; PG8_LDA(At, 0, 0); PG8_STAGE(PG8_SA(1, 1), a1 + hstep, voffA);
            PG8_WAIT_V(8); PG8_WAIT_L(0); PG8_BAR; PG8_MMA(0, 0, At, B0); PG8_MMA(0, 1, At, B1); PG8_BAR; PG8_SCHED;
            PG8_LDA(At, 0, 1); PG8_STAGE(PG8_SB(0, 0), b2, voffB); PG8_STAGE(PG8_SB(0, 1), b2 + hstep, voffB); PG8_STAGE(PG8_SA(0, 0), a2, voffA);
            PG8_WAIT_V(8); PG8_WAIT_L(0); PG8_BAR; PG8_MMA(1, 0, At, B0); PG8_MMA(1, 1, At, B1); PG8_BAR; PG8_SCHED;
            PG8_LDB(B0, 1, 0); PG8_LDB(B1, 1, 1); PG8_SCHED; PG8_LDA(At, 1, 0); PG8_STAGE(PG8_SA(0, 1), a2 + hstep, voffA);
            PG8_WAIT_V(8); PG8_WAIT_L(0); PG8_BAR; PG8_MMA(0, 0, At, B0); PG8_MMA(0, 1, At, B1); PG8_BAR; PG8_SCHED;
            PG8_LDA(At, 1, 1); PG8_STAGE(PG8_SB(1, 0), b3, voffB); PG8_STAGE(PG8_SB(1, 1), b3 + hstep, voffB); PG8_STAGE(PG8_SA(1, 0), a3, voffA);
            PG8_WAIT_V(8); PG8_WAIT_L(0); PG8_BAR; PG8_MMA(1, 0, At, B0); PG8_MMA(1, 1, At, B1); PG8_BAR; PG8_SCHED;
            } else {
            PG8_LDB(B0, 0, 0); PG8_SCHED; PG8_LDA(At, 0, 0); PG8_STAGE(PG8_SA(1, 1), a1 + hstep, voffA);
            PG8_WAIT_L(8); PG8_BAR; PG8_WAIT_L(0); PG8_MMA(0, 0, At, B0); PG8_BAR; PG8_SCHED;
            PG8_LDB(B1, 0, 1); PG8_STAGE(PG8_SB(0, 0), b2, voffB);
            PG8_BAR; PG8_WAIT_L(0); PG8_MMA(0, 1, At, B1); PG8_BAR;
            PG8_LDA(At, 0, 1); PG8_STAGE(PG8_SA(0, 0), a2, voffA);
            PG8_BAR; PG8_WAIT_L(0); PG8_MMA(1, 0, At, B0); PG8_BAR; PG8_SCHED;
            PG8_STAGE(PG8_SB(0, 1), b2 + hstep, voffB);
            PG8_WAIT_V(6); PG8_BAR; PG8_MMA(1, 1, At, B1); PG8_BAR;
            PG8_LDB(B0, 1, 0); PG8_SCHED; PG8_LDA(At, 1, 0); PG8_STAGE(PG8_SA(0, 1), a2 + hstep, voffA);
            PG8_WAIT_L(8); PG8_BAR; PG8_WAIT_L(0); PG8_MMA(0, 0, At, B0); PG8_BAR; PG8_SCHED;
            PG8_LDB(B1, 1, 1); PG8_STAGE(PG8_SB(1, 0), b3, voffB);
            PG8_BAR; PG8_WAIT_L(0); PG8_MMA(0, 1, At, B1); PG8_BAR;
            PG8_LDA(At, 1, 1); PG8_STAGE(PG8_SA(1, 0), a3, voffA);
            PG8_BAR; PG8_WAIT_L(0); PG8_MMA(1, 0, At, B0); PG8_BAR; PG8_SCHED;
            PG8_STAGE(PG8_SB(1, 1), b3 + hstep, voffB);
            PG8_WAIT_V(6); PG8_BAR; PG8_MMA(1, 1, At, B1); PG8_BAR;
            }
        }
        if constexpr (ALIGN_EPI) { if (wr == 0) PG8_BAR; }
        if constexpr (!Epi::AFTER_DRAIN) { E(acc, cur, wr, wc, fr, fq); S.done(cur); }
        if (!has_next) break;
#pragma unroll
        for (int a = 0; a < 2; ++a)
#pragma unroll
            for (int b = 0; b < 2; ++b)
#pragma unroll
                for (int m = 0; m < 4; ++m)
#pragma unroll
                    for (int n = 0; n < 2; ++n) acc[a][b][m][n] = (f32x4){0.f, 0.f, 0.f, 0.f};
        cur = nxt; cA = nA; cB = nB; ++ui;
        if constexpr (ALIGN_EPI) { if (wr == 1) PG8_BAR; }
    }
    PG8_WAIT_V(0);
    if constexpr (!ALIGN_EPI) { if (wr == 0) PG8_BAR; }
    PG8_BAR;
    if constexpr (Epi::AFTER_DRAIN) { E.fused(acc, cur, wr, wc, fr, fq, lds, wid, lane); S.done(cur); }
#undef PG8_SA
#undef PG8_SB
#undef PG8_STAGE
#undef PG8_LDA
#undef PG8_LDB
#undef PG8_MMA
#undef PG8_WAIT_V
#undef PG8_WAIT_L
#undef PG8_BAR
#undef PG8_SCHED
}
}

using pg8::bf16_t; using pg8::bf16x8; using pg8::f32x4; using pg8::u32x4;
typedef float f32x16 __attribute__((ext_vector_type(16)));
typedef unsigned u32x2 __attribute__((ext_vector_type(2)));
typedef float f32x2_t __attribute__((ext_vector_type(2)));
typedef __bf16 bf16x2_t __attribute__((ext_vector_type(2)));
#define LAS __attribute__((address_space(3)))
#define DI __device__ __forceinline__
#define WAVE_LDS_SYNC() asm volatile("s_waitcnt lgkmcnt(0)" ::: "memory")
#define MFMA32(a, b, c) __builtin_amdgcn_mfma_f32_32x32x16_bf16((a), (b), (c), 0, 0, 0)

DI unsigned pk2(float lo, float hi) { f32x2_t v = {lo, hi}; bf16x2_t b = __builtin_convertvector(v, bf16x2_t); return __builtin_bit_cast(unsigned, b); }
DI float bflo(unsigned u) { return __uint_as_float(u << 16); }
DI float bfhi(unsigned u) { return __uint_as_float(u & 0xffff0000u); }
DI float bf2f(bf16_t b) { return __uint_as_float((unsigned)b << 16); }
DI bf16_t f2bf(float f) { return (bf16_t)(pk2(f, 0.f) & 0xffffu); }
template <class T> DI T sgpr_pin(T v) { asm volatile("" : "+s"(v)); return v; }
DI int crow(int r, int hi) { return (r & 3) + 8 * (r >> 2) + 4 * hi; }
DI float sigmoidf_(float x) { return 1.f / (1.f + __expf(-x)); }

constexpr int DM = 1024, TP = 4096, TS = 16384, TT = 20480, DFF = 2816, NMODW = 9216;
constexpr int NPE = 768, NPO = 3840;
constexpr float EPS = 1e-6f;
constexpr int NTHREADS = 512, NWAVES = 8;
constexpr int LDS_BYTES = 155648;

constexpr size_t MiB = 1u << 20;
constexpr size_t WS_WFI = 0, WS_WFO = 88 * MiB, WS_WIE = 132 * MiB, WS_WOE = 139 * MiB, WS_WIO = 143 * MiB, WS_WOO = 158 * MiB;
constexpr size_t WS_MOD = 162 * MiB, WS_ROPE = 163 * MiB, WS_DS = 164 * MiB, WS_DP = 228 * MiB;
constexpr size_t WS_CKA = 229 * MiB, WS_CVA = 229 * MiB + 512 * 1024, WS_CKC = 230 * MiB, WS_CVC = 232 * MiB, WS_GATES = 234 * MiB;
constexpr size_t WS_HN = 236 * MiB, WS_ACT = 276 * MiB  , WS_MIX = 426 * MiB, WS_U = 466 * MiB;
constexpr size_t WS_PQT = WS_U, WS_QA = WS_U + 40 * MiB, WS_KA = WS_U + 60 * MiB, WS_PQF = WS_U + 66 * MiB;
constexpr size_t WS_QC = WS_U, WS_KC = WS_U + 20 * MiB, WS_LB = WS_U + 40 * MiB, WS_CPREV = WS_U + 120 * MiB;
constexpr size_t WS_NL = WS_U + 160 * MiB, WS_NPREV = WS_U + 161 * MiB, WS_SCAL = WS_U + 162 * MiB;
constexpr size_t WS_END = WS_U + 163 * MiB;
constexpr size_t WS_O0 = WS_END + MiB, WS_XB = WS_END + 18 * MiB;
constexpr int HPS = 2112, HPP = 192;
constexpr size_t PQF_S0 = (size_t)16 * 512 * 2 * HPP;
constexpr int NUNIT = 640;

constexpr size_t O_KA = 20971520, O_VA = 22020096, O_KC = 23068672, O_VC = 27262976, O_CD = 31457280, O_ND = 35651584, O_MD = 35684352;

struct Args { const float* in[29]; float* out; unsigned char* ws; };

struct EpiSwiglu {
    static constexpr bool PERM = true, AFTER_DRAIN = false;
    bf16_t* O;
    DI void operator()(const f32x4 (&acc)[2][2][4][2], const pg8::Unit& u, int wr, int wc, int fr, int fq) const {
        const int row0 = u.pm * 256 + wr * 64 + fr, col0 = u.pn * 128 + wc * 32 + 8 * fq;
#pragma unroll
        for (int ai = 0; ai < 2; ++ai)
#pragma unroll
            for (int m = 0; m < 4; ++m) {
                bf16_t* rowp = O + (size_t)(row0 + ai * 128 + m * 16) * DFF + col0;
                float v[8];
#pragma unroll
                for (int n = 0; n < 2; ++n)
#pragma unroll
                    for (int e = 0; e < 4; ++e) { const float g = acc[ai][0][m][n][e], up = acc[ai][1][m][n][e]; v[n * 4 + e] = g * up * __builtin_amdgcn_rcpf(1.f + __expf(-g)); }
                u32x4 w; w.x = pk2(v[0], v[1]); w.y = pk2(v[2], v[3]); w.z = pk2(v[4], v[5]); w.w = pk2(v[6], v[7]);
                *(u32x4*)rowp = w;
            }
    }
};
struct EpiResid {
    static constexpr bool PERM = true, AFTER_DRAIN = false;
    bf16_t* XB; float* Xout; const float* Rp; const float* Rs; const float* modg; float coef; int mode;
    DI void operator()(const f32x4 (&acc)[2][2][4][2], const pg8::Unit& u, int wr, int wc, int fr, int fq) const {
        const int v = u.pm < 16 ? 0 : 1 + ((u.pm - 16) >> 4);
        const int col0 = u.pn * 256 + wc * 32 + 8 * fq, row0 = u.pm * 256 + wr * 64 + fr;
        const float* R = u.pm < 16 ? Rp : Rs - (size_t)TP * DM;
        const bool rin = (mode & 1) != 0, wout = (mode & 2) != 0;
#pragma unroll
        for (int bj = 0; bj < 2; ++bj) {
            const f32x4 g0 = *(const f32x4*)(modg + (size_t)v * NMODW + col0 + bj * 128) * coef, g1 = *(const f32x4*)(modg + (size_t)v * NMODW + col0 + bj * 128 + 4) * coef;
#pragma unroll
            for (int ai = 0; ai < 2; ++ai) {
                if (!(u.qm & (1 << (2 * ai + bj)))) continue;
                f32x4 x0[4], x1[4];
                if (rin) {
#pragma unroll
                    for (int m = 0; m < 4; ++m) { const float* p = R + (size_t)(row0 + ai * 128 + m * 16) * DM + col0 + bj * 128; x0[m] = *(const f32x4*)p; x1[m] = *(const f32x4*)(p + 4); }
                } else {
                    u32x4 xr[4];
#pragma unroll
                    for (int m = 0; m < 4; ++m) xr[m] = *(const u32x4*)(XB + (size_t)(row0 + ai * 128 + m * 16) * DM + col0 + bj * 128);
#pragma unroll
                    for (int m = 0; m < 4; ++m) { x0[m] = (f32x4){bflo(xr[m].x), bfhi(xr[m].x), bflo(xr[m].y), bfhi(xr[m].y)}; x1[m] = (f32x4){bflo(xr[m].z), bfhi(xr[m].z), bflo(xr[m].w), bfhi(xr[m].w)}; }
                }
#pragma unroll
                for (int m = 0; m < 4; ++m) {
                    const size_t off = (size_t)(row0 + ai * 128 + m * 16) * DM + col0 + bj * 128;
                    const f32x4 y0 = x0[m] + g0 * acc[ai][bj][m][0], y1 = x1[m] + g1 * acc[ai][bj][m][1];
                    if (wout) { *(f32x4*)(Xout + off) = y0; *(f32x4*)(Xout + off + 4) = y1; }
                    else { u32x4 w; w.x = pk2(y0[0], y0[1]); w.y = pk2(y0[2], y0[3]); w.z = pk2(y1[0], y1[1]); w.w = pk2(y1[2], y1[3]); *(u32x4*)(XB + off) = w; }
                }
            }
        }
    }
};
template <int MODE> struct EpiStore {
    static constexpr bool PERM = true, AFTER_DRAIN = false;
    bf16_t* O; int ldc; float scale; float* gates; int tokbase; int S;
    DI void operator()(const f32x4 (&acc)[2][2][4][2], const pg8::Unit& u, int wr, int wc, int fr, int fq) const {
#pragma unroll
        for (int ai = 0; ai < 2; ++ai)
#pragma unroll
            for (int m = 0; m < 4; ++m) {
                const int row = u.pm * 256 + ai * 128 + wr * 64 + m * 16 + fr;
#pragma unroll
                for (int bj = 0; bj < 2; ++bj) {
                    const int cin = bj * 128 + wc * 32 + 8 * fq;
                    f32x4 v0 = acc[ai][bj][m][0], v1 = acc[ai][bj][m][1];
                    bf16_t* p;
                    if (MODE == 0) { p = O + (size_t)row * ldc + u.pn * 256 + cin; }
                    else if (MODE == 1) {
                        const int g = row >> 8, which = (row >> 7) & 1, j = row & 127, tok = u.pn * 256 + cin;
                        if (tok < TP) { const int b = tok >> 8, s = tok & 255; p = O + ((size_t)((b * 512 + g * 128 + j) * 2 + which) * 256 + s); }
                        else { const int t2 = tok - TP, b = t2 >> 12, s = t2 & 4095; p = O + (size_t)4194304 + ((size_t)((b * 512 + g * 128 + j) * 2 + which) * 4096 + s); }
                    } else {
                        const int b = u.pn >> 1, cn = (u.pn & 1) * 256 + cin;
                        p = O + (size_t)(tokbase + b * S + row) * DM + 512 + cn;
                        v0 *= scale; v1 *= scale;
                    }
                    u32x4 w; w.x = pk2(v0[0], v0[1]); w.y = pk2(v0[2], v0[3]); w.z = pk2(v1[0], v1[1]); w.w = pk2(v1[2], v1[3]);
                    *(u32x4*)p = w;
                    if (MODE == 0) { if (ldc == NPO && u.pn == 14 && bj == 0 && wc == 0 && fq < 2) {
                        float* gp = gates + (size_t)row * 16 + 8 * fq;
                        *(f32x4*)gp = acc[ai][bj][m][0]; *(f32x4*)(gp + 4) = acc[ai][bj][m][1];
                    } }
                }
            }
    }
};
struct EpiResidTail {
    static constexpr bool PERM = false, AFTER_DRAIN = true;
    EpiResid base; float* tmp; unsigned* flag; int khalf;
    DI void fused(f32x4 (&acc)[2][2][4][2], const pg8::Unit& u, int wr, int wc, int fr, int fq, LAS unsigned char*, int, int) const {
        float* const t0 = sgpr_pin(tmp) + (size_t)(wr * 64 + fr) * 256 + wc * 32 + 4 * fq;
        if (khalf == 1) {
#pragma unroll
            for (int ai = 0; ai < 2; ++ai)
#pragma unroll
                for (int m = 0; m < 4; ++m)
#pragma unroll
                    for (int bj = 0; bj < 2; ++bj)
#pragma unroll
                        for (int n = 0; n < 2; ++n) *(f32x4*)(t0 + (size_t)(ai * 128 + m * 16) * 256 + bj * 128 + n * 16) = acc[ai][bj][m][n];
            asm volatile("s_waitcnt vmcnt(0)" ::: "memory");
            __syncthreads();
            if (threadIdx.x == 0) { __builtin_amdgcn_fence(__ATOMIC_RELEASE, "agent"); asm volatile("s_waitcnt vmcnt(0)" ::: "memory"); __hip_atomic_store(flag, 1u, __ATOMIC_RELAXED, __HIP_MEMORY_SCOPE_AGENT); }
        } else {
            if (threadIdx.x == 0) {
                unsigned sp = 0;
                while (__hip_atomic_load(flag, __ATOMIC_RELAXED, __HIP_MEMORY_SCOPE_AGENT) == 0u) { __builtin_amdgcn_s_sleep(2); if (++sp > (1u << 18)) break; }
                __builtin_amdgcn_fence(__ATOMIC_ACQUIRE, "agent"); asm volatile("s_waitcnt vmcnt(0)" ::: "memory");
            }
            __syncthreads();
#pragma unroll
            for (int ai = 0; ai < 2; ++ai)
#pragma unroll
                for (int m = 0; m < 4; ++m)
                {
#pragma unroll
                    for (int bj = 0; bj < 2; ++bj)
#pragma unroll
                        for (int n = 0; n < 2; ++n) acc[ai][bj][m][n] += *(const f32x4*)(t0 + (size_t)(ai * 128 + m * 16) * 256 + bj * 128 + n * 16);
                    asm volatile("" : "+v"(acc[ai][0][m][0]), "+v"(acc[ai][0][m][1]), "+v"(acc[ai][1][m][0]), "+v"(acc[ai][1][m][1]) :: "memory");
                }
            base(acc, u, wr, wc, fr, fq);
        }
    }
};
struct FullRounds {
    pg8::StaticOrder so; int nfr;
    DI void init(int M, int N, int G, int c) { so.init(M, N, G, c); nfr = so.nwg / G; }
    DI bool next(int i, pg8::Unit& u) const { return i < nfr && so.next(i, u); }
    DI void a_ready(const pg8::Unit&) const {}
    DI void done(const pg8::Unit&) const {}
};
struct HalfTail {
    pg8::StaticOrder so; int uidx;
    DI void init(int M, int N, int G, int c) { so.init(M, N, G, c); const int nfr = so.nwg / G, rem = so.nwg - nfr * G; uidx = c < 2 * rem ? nfr * G + (c >> 1) : -1; }
    DI bool next(int i, pg8::Unit& u) const { if (i != 0 || uidx < 0) return false; pg8::StaticOrder t = so; t.c = uidx; t.G = 0; return t.next(0, u); }
    DI void a_ready(const pg8::Unit&) const {}
    DI void done(const pg8::Unit&) const {}
};
struct TailOrder {
    pg8::StaticOrder so; int nfr, rem;
    DI void init(int M, int N, int G, int c) { so.init(M, N, G, c); nfr = so.nwg / G; rem = so.nwg - nfr * G; }
    DI bool next(int i, pg8::Unit& u) const {
        if (i < nfr) return so.next(i, u);
        const int j = (i - nfr) * so.G + so.c; if (j >= rem * 4) return false;
        pg8::StaticOrder t = so; t.c = nfr * so.G + (j >> 2) - 0; t.G = 0;
        t.next(0, u); u.qm = 1 << (j & 3); return true; }
    DI void a_ready(const pg8::Unit&) const {}
    DI void done(const pg8::Unit&) const {}
};
struct SimpleOrder {
    int nM, nN, G, c, sq;
    DI bool next(int i, pg8::Unit& u) const { const int idx = i * G + c; if (idx >= nM * nN) return false;
        if (sq && nM == 16 && nN == 8) { const int x = idx & 7, j = idx >> 3; u.pm = (x & 3) * 4 + (j & 3); u.pn = (x >> 2) * 4 + (j >> 2); }
        else { u.pm = idx % nM; u.pn = idx / nM; }
        u.qm = 15; return true; }
    DI void a_ready(const pg8::Unit&) const {}
    DI void done(const pg8::Unit&) const {}
};

DI void transpose_item(const float* W, int K, int ldw, int N, int Npad, bf16_t* WT, int mode, LAS float* scr, int item, int lane) {
    const int nblk = Npad / 32, kb = item / nblk, nb = item - kb * nblk, k0 = 64 * kb, n0 = 32 * nb;
    const int n = n0 + (lane & 31);
    float tv[32];
#pragma unroll
    for (int i = 0; i < 32; ++i) { const int kk = 2 * i + (lane >> 5); tv[i] = (n < N) ? __builtin_nontemporal_load(W + (size_t)(k0 + kk) * ldw + n) : 0.f; }
#pragma unroll
    for (int i = 0; i < 32; ++i) { const int kk = 2 * i + (lane >> 5); scr[kk * 33 + (lane & 31)] = tv[i]; }
    WAVE_LDS_SYNC();
    const int c = lane & 7;
#pragma unroll
    for (int j = 0; j < 4; ++j) {
        const int nl = (lane >> 3) + 8 * j, nn = n0 + nl;
        const LAS float* s = scr + (8 * c) * 33 + nl;
        float sc = 1.f; int row = nn;
        if (mode == 1) { const int half = nn >= DFF ? 1 : 0, jj = nn - half * DFF; row = (jj >> 7) * 256 + half * 128 + (jj & 127); }
        else if (mode == 2) { if (nn >= 2048 && nn < 2560) sc = 0.08838834764831845f; }
        u32x4 o; o.x = pk2(s[0] * sc, s[33] * sc); o.y = pk2(s[66] * sc, s[99] * sc); o.z = pk2(s[132] * sc, s[165] * sc); o.w = pk2(s[198] * sc, s[231] * sc);
        *(u32x4*)(WT + (size_t)row * K + k0 + 8 * c) = o;
    }
    WAVE_LDS_SYNC();
}

DI void prepass(const Args& a, LAS unsigned char* lds) {
    const int tid = tid_opaque(), lane = tid & 63, wid = tid >> 6, G = gridDim.x;
    unsigned char* ws = a.ws;
#define PRE_GT() const size_t gt = (size_t)bid_opaque() * NTHREADS + tid_opaque(), NGT = (size_t)G * NTHREADS
    {
        PRE_GT();
        const size_t n4[4] = {262144 / 4, 262144 / 4, 1048576 / 4, 1048576 / 4};
        const size_t offs[4] = {WS_CKA, WS_CVA, WS_CKC, WS_CVC};
#pragma unroll
        for (int q = 0; q < 4; ++q) {
            const f32x4* src = (const f32x4*)a.in[3 + q]; u32x2* dst = (u32x2*)(ws + offs[q]);
            for (size_t i = gt; i < n4[q]; i += NGT) { const f32x4 v = src[i]; u32x2 w; w.x = pk2(v[0], v[1]); w.y = pk2(v[2], v[3]); dst[i] = w; }
        }
    }
    {
        PRE_GT();
        float* R = (float*)(ws + WS_ROPE);
        for (size_t i = gt; i < 4096 * 32; i += NGT) {
            const int pos = (int)(i >> 5), af = (int)(i & 31), ax = af >> 4, f = af & 15;
            const float inv = exp2f(-(float)f * (13.287712379549449f / 16.f));
            const float ang = (float)(ax == 0 ? (pos >> 6) : (pos & 63)) * inv;
            R[pos * 64 + af] = __cosf(ang); R[pos * 64 + 32 + af] = __sinf(ang);
        }
    }
    {
        PRE_GT();
        u32x4* D = (u32x4*)(ws + WS_DS);
        for (size_t it = gt; it < (size_t)4096 * (2 * HPS / 8); it += NGT) {
            const int k = (int)(it / (2 * HPS / 8)), c8 = (int)(it - (size_t)k * (2 * HPS / 8)) * 8; float v[8];
#pragma unroll
            for (int e = 0; e < 8; ++e) { const int c = c8 + e, part = c >= HPS ? 1 : 0, cc = c - part * HPS; int idx = (k * cc) & 4095; if (idx >= 2048) idx -= 4096; const float ang = (float)idx * (6.283185307179586f / 4096.f);
                v[e] = cc <= 2048 ? (part ? -__sinf(ang) : __cosf(ang)) : 0.f; }
            u32x4 w; w.x = pk2(v[0], v[1]); w.y = pk2(v[2], v[3]); w.z = pk2(v[4], v[5]); w.w = pk2(v[6], v[7]); D[it] = w;
        }
        u32x4* Dp = (u32x4*)(ws + WS_DP);
        for (size_t it = gt; it < (size_t)256 * (2 * HPP / 8); it += NGT) {
            const int k = (int)(it / (2 * HPP / 8)), c8 = (int)(it - (size_t)k * (2 * HPP / 8)) * 8; float v[8];
#pragma unroll
            for (int e = 0; e < 8; ++e) { const int c = c8 + e, part = c >= HPP ? 1 : 0, cc = c - part * HPP; int idx = (k * cc) & 255; if (idx >= 128) idx -= 256; const float ang = (float)idx * (6.283185307179586f / 256.f);
                v[e] = cc <= 128 ? (part ? -__sinf(ang) : __cosf(ang)) : 0.f; }
            u32x4 w; w.x = pk2(v[0], v[1]); w.y = pk2(v[2], v[3]); w.z = pk2(v[4], v[5]); w.w = pk2(v[6], v[7]); Dp[it] = w;
        }
    }
    {
        const int gw = bid_opaque() * NWAVES + wid, NGW = G * NWAVES;
        LAS float* scr = (LAS float*)(lds + wid * 8448);
        constexpr int I_FI = 2816, I_FO = 1408, I_IE = 384, I_OE = 512, I_IO = 1920, I_OO = 512;
        constexpr int NIT = 8 * I_FI + 8 * I_FO + 2 * I_IE + 2 * I_OE + 2 * I_IO + 2 * I_OO;
        for (int it = gw; it < NIT; it += NGW) {
            int r = it;
            if (r < 8 * I_FI) { const int mi = r / I_FI; transpose_item(a.in[14] + (size_t)mi * DM * 2 * DFF, DM, 2 * DFF, 2 * DFF, 2 * DFF, (bf16_t*)(ws + WS_WFI) + (size_t)mi * 2 * DFF * DM, 1, scr, r - mi * I_FI, lane); continue; } r -= 8 * I_FI;
            if (r < 8 * I_FO) { const int mi = r / I_FO; transpose_item(a.in[15] + (size_t)mi * DFF * DM, DFF, DM, DM, DM, (bf16_t*)(ws + WS_WFO) + (size_t)mi * DM * DFF, 0, scr, r - mi * I_FO, lane); continue; } r -= 8 * I_FO;
            if (r < 2 * I_IE) { const int mi = r / I_IE; transpose_item(a.in[16] + (size_t)mi * DM * 1280, DM, 1280, 768, 768, (bf16_t*)(ws + WS_WIE) + (size_t)mi * 1792 * DM, 0, scr, r - mi * I_IE, lane); continue; } r -= 2 * I_IE;
            if (r < 2 * I_OE) { const int mi = r / I_OE; transpose_item(a.in[17] + (size_t)mi * DM * DM, DM, DM, DM, DM, (bf16_t*)(ws + WS_WOE) + (size_t)mi * DM * DM, 0, scr, r - mi * I_OE, lane); continue; } r -= 2 * I_OE;
            if (r < 2 * I_IO) { const int mi = r / I_IO; transpose_item(a.in[21] + (size_t)mi * DM * 3600, DM, 3600, 3600, NPO, (bf16_t*)(ws + WS_WIO) + (size_t)mi * NPO * DM, 2, scr, r - mi * I_IO, lane); continue; } r -= 2 * I_IO;
            { const int mi = r / I_OO; transpose_item(a.in[23] + (size_t)mi * DM * DM, DM, DM, DM, DM, (bf16_t*)(ws + WS_WOO) + (size_t)mi * DM * DM, 0, scr, r - mi * I_OO, lane); }
        }
    }
    __syncthreads();
    {
        LAS float* Wl = (LAS float*)lds; LAS float* tab = Wl + 64 * 129;
        for (int it = bid_opaque(); it < 128; it += G) {
            const int li = it >> 6, g = (it >> 4) & 3, kb = it & 15;
            const float* Wsrc = a.in[16] + (size_t)li * DM * 1280;
            for (int e = tid; e < 64 * 128; e += NTHREADS) { const int k = e >> 7, c = e & 127; Wl[k * 129 + c] = Wsrc[(size_t)(kb * 64 + k) * 1280 + 768 + g * 128 + c]; }
            if (tid < 128) { const float ang = (float)tid * (6.283185307179586f / 128.f); tab[tid] = __cosf(ang); tab[128 + tid] = __sinf(ang); }
            __syncthreads();
            const int k = tid & 63, nb = tid >> 6;
            bf16_t* dst = (bf16_t*)(ws + WS_WIE) + (size_t)li * 1792 * DM;
#pragma unroll 1
            for (int ii = 0; ii < 32; ++ii) {
                const int n = nb + 8 * ii, which = n >> 7, j = n & 127; float acc = 0.f;
#pragma unroll 8
                for (int c = 0; c < 128; ++c) acc += Wl[k * 129 + c] * tab[which * 128 + ((c * j) & 127)];
                dst[(size_t)(768 + g * 256 + n) * DM + kb * 64 + k] = f2bf(acc);
            }
            __syncthreads();
        }
    }
    {
        LAS float* S5 = (LAS float*)lds; LAS float* part = S5 + 5120;
        for (int e = tid; e < 5120; e += NTHREADS) { const int v = e >> 10, k = e & 1023; const float x = v == 0 ? a.in[10][k] : a.in[2][(v - 1) * 1024 + k]; S5[e] = x / (1.f + __expf(-x)); }
        __syncthreads();
        float* MOD = (float*)(ws + WS_MOD);
        for (int it = bid_opaque(); it < 576; it += G) {
            const int l = it / 144, cgp = it - l * 144, n = cgp * 64 + lane;
            float acc[5] = {0.f, 0.f, 0.f, 0.f, 0.f};
            const float* W = a.in[11] + ((size_t)l * DM + wid * 128) * NMODW + n;
#pragma unroll 1
            for (int k8 = 0; k8 < 128; k8 += 16) {
                float wv[16];
#pragma unroll
                for (int q = 0; q < 16; ++q) wv[q] = __builtin_nontemporal_load(W + (size_t)(k8 + q) * NMODW);
#pragma unroll
                for (int q = 0; q < 16; ++q)
#pragma unroll
                    for (int v = 0; v < 5; ++v) acc[v] += S5[v * 1024 + wid * 128 + k8 + q] * wv[q];
            }
#pragma unroll
            for (int v = 0; v < 5; ++v) part[(wid * 5 + v) * 64 + lane] = acc[v];
            __syncthreads();
            if (tid < 320) { const int v = tid >> 6, ln = tid & 63; float s = a.in[12][(size_t)l * NMODW + cgp * 64 + ln];
#pragma unroll
                for (int w = 0; w < 8; ++w) s += part[(w * 5 + v) * 64 + ln];
                MOD[((size_t)l * 5 + v) * NMODW + cgp * 64 + ln] = s; }
            __syncthreads();
        }
    }
}

DI void norm_row(int row, int lane, const float* Xp, const float* Xs, bf16_t* HN, const float* g, const float* modl, int j) {
    const int v = row < TP ? 0 : 1 + ((row - TP) >> 12);
    const f32x4* xr = (const f32x4*)(row < TP ? Xp + (size_t)row * DM : Xs + (size_t)(row - TP) * DM) + lane;
    const f32x4* gr = (const f32x4*)g + lane;
    const f32x4* sh = (const f32x4*)(modl + (size_t)v * NMODW + (3 * j) * DM) + lane;
    const f32x4* sc = (const f32x4*)(modl + (size_t)v * NMODW + (3 * j + 1) * DM) + lane;
    f32x4 x[4]; float ss = 0.f;
#pragma unroll
    for (int q = 0; q < 4; ++q) { x[q] = xr[64 * q]; ss += (x[q][0] * x[q][0] + x[q][1] * x[q][1]) + (x[q][2] * x[q][2] + x[q][3] * x[q][3]); }
#pragma unroll
    for (int o = 1; o < 64; o <<= 1) ss += __shfl_xor(ss, o);
    const float rinv = rsqrtf(ss * (1.f / DM) + EPS);
    u32x2* o8 = (u32x2*)(HN + (size_t)row * DM) + lane;
#pragma unroll
    for (int q = 0; q < 4; ++q) { const f32x4 y = x[q] * rinv * gr[64 * q] * (sc[64 * q] + 1.f) + sh[64 * q]; u32x2 w; w.x = pk2(y[0], y[1]); w.y = pk2(y[2], y[3]); o8[64 * q] = w; }
}
DI void norm_phase(const float* Xp, const float* Xs, const bf16_t* XB, bf16_t* HN, const float* g, const float* modl, int j) {
    const int tid = tid_opaque(), lane = tid & 63, wid = tid >> 6;
    const int gw = bid_opaque() * NWAVES + wid, NGW = gridDim.x * NWAVES;
#define CI(q) ((((q) >> 1) * 128) + 2 * lane + ((q) & 1))
    for (int row = gw; row < TT; row += 2 * NGW) {
        const int rowb0 = row + NGW; const bool hb = rowb0 < TT; const int rowb = hb ? rowb0 : row;
        f32x4 x[4], y[4];
        if (XB != nullptr) {
            const u32x4* xa = (const u32x4*)(XB + (size_t)row * DM); const u32x4* xb = (const u32x4*)(XB + (size_t)rowb * DM);
            const u32x4 ra0 = xa[lane], ra1 = xa[64 + lane], rb0 = xb[lane], rb1 = xb[64 + lane];
            x[0] = (f32x4){bflo(ra0.x), bfhi(ra0.x), bflo(ra0.y), bfhi(ra0.y)}; x[1] = (f32x4){bflo(ra0.z), bfhi(ra0.z), bflo(ra0.w), bfhi(ra0.w)};
            x[2] = (f32x4){bflo(ra1.x), bfhi(ra1.x), bflo(ra1.y), bfhi(ra1.y)}; x[3] = (f32x4){bflo(ra1.z), bfhi(ra1.z), bflo(ra1.w), bfhi(ra1.w)};
            y[0] = (f32x4){bflo(rb0.x), bfhi(rb0.x), bflo(rb0.y), bfhi(rb0.y)}; y[1] = (f32x4){bflo(rb0.z), bfhi(rb0.z), bflo(rb0.w), bfhi(rb0.w)};
            y[2] = (f32x4){bflo(rb1.x), bfhi(rb1.x), bflo(rb1.y), bfhi(rb1.y)}; y[3] = (f32x4){bflo(rb1.z), bfhi(rb1.z), bflo(rb1.w), bfhi(rb1.w)};
        } else {
            const f32x4* xa = (const f32x4*)(row < TP ? Xp + (size_t)row * DM : Xs + (size_t)(row - TP) * DM);
            const f32x4* xb = (const f32x4*)(rowb < TP ? Xp + (size_t)rowb * DM : Xs + (size_t)(rowb - TP) * DM);
#pragma unroll
            for (int q = 0; q < 4; ++q) { x[q] = xa[CI(q)]; y[q] = xb[CI(q)]; }
        }
        float ss = 0.f, st = 0.f;
#pragma unroll
        for (int q = 0; q < 4; ++q) { ss += (x[q][0] * x[q][0] + x[q][1] * x[q][1]) + (x[q][2] * x[q][2] + x[q][3] * x[q][3]); st += (y[q][0] * y[q][0] + y[q][1] * y[q][1]) + (y[q][2] * y[q][2] + y[q][3] * y[q][3]); }
#pragma unroll
        for (int o = 1; o < 64; o <<= 1) { ss += __shfl_xor(ss, o); st += __shfl_xor(st, o); }
        const f32x4* gr = (const f32x4*)g;
#pragma unroll
        for (int h = 0; h < 2; ++h) {
            if (h == 1 && !hb) break;
            const int r = h ? rowb : row; const int v = r < TP ? 0 : 1 + ((r - TP) >> 12);
            const f32x4* sh = (const f32x4*)(modl + (size_t)v * NMODW + (3 * j) * DM);
            const f32x4* sc = (const f32x4*)(modl + (size_t)v * NMODW + (3 * j + 1) * DM);
            const float rinv = rsqrtf((h ? st : ss) * (1.f / DM) + EPS);
            f32x4 z[4];
#pragma unroll
            for (int q = 0; q < 4; ++q) z[q] = (h ? y[q] : x[q]) * rinv * gr[CI(q)] * (sc[CI(q)] + 1.f) + sh[CI(q)];
            u32x4* o16 = (u32x4*)(HN + (size_t)r * DM);
#pragma unroll
            for (int h2 = 0; h2 < 2; ++h2) { u32x4 w; w.x = pk2(z[2 * h2][0], z[2 * h2][1]); w.y = pk2(z[2 * h2][2], z[2 * h2][3]); w.z = pk2(z[2 * h2 + 1][0], z[2 * h2 + 1][1]); w.w = pk2(z[2 * h2 + 1][2], z[2 * h2 + 1][3]); o16[h2 * 64 + lane] = w; }
        }
    }
#undef CI
}
DI void norm_after_resid(unsigned* cnt, const float* X, bf16_t* HN, const float* g, const float* modl, int j) {
    const int tid = tid_opaque(), lane = tid & 63, wid = tid >> 6, G = gridDim.x, c = bid_opaque();
    const int r0 = (int)((long)TT * c / G), r1 = (int)((long)TT * (c + 1) / G);
    if (tid == 0) {
        for (int p = r0 >> 8; p <= (r1 - 1) >> 8; ++p) {
            unsigned sp = 0;
            while (__hip_atomic_load(cnt + p, __ATOMIC_RELAXED, __HIP_MEMORY_SCOPE_AGENT) < 4u) { __builtin_amdgcn_s_sleep(2); if (++sp > (1u << 18)) break; }
        }
        __builtin_amdgcn_fence(__ATOMIC_ACQUIRE, "agent"); asm volatile("s_waitcnt vmcnt(0)" ::: "memory");
    }
    __syncthreads();
    for (int row = r0 + wid; row < r1; row += NWAVES) norm_row(row, lane, X, X + (size_t)TP * DM, HN, g, modl, j);
}

DI void normrope_block(const u32x4 raw, int nact, const float* gw64, bool rope, const float* ropetab, bf16_t* dst, float* dst32, int lane) {
    float x[8];
    if (lane < nact) { x[0] = bflo(raw.x); x[1] = bfhi(raw.x); x[2] = bflo(raw.y); x[3] = bfhi(raw.y); x[4] = bflo(raw.z); x[5] = bfhi(raw.z); x[6] = bflo(raw.w); x[7] = bfhi(raw.w); }
    else {
#pragma unroll
        for (int e = 0; e < 8; ++e) x[e] = 0.f; }
    float ss = 0.f;
#pragma unroll
    for (int e = 0; e < 8; ++e) ss += x[e] * x[e];
    ss += __shfl_xor(ss, 1); ss += __shfl_xor(ss, 2); ss += __shfl_xor(ss, 4);
    const float rinv = rsqrtf(ss * (1.f / 64.f) + EPS);
    const int j = lane & 7;
    float y[8];
#pragma unroll
    for (int e = 0; e < 8; ++e) y[e] = x[e] * rinv * gw64[8 * j + e];
    if (dst32 != nullptr && lane < nact) { *(f32x4*)(dst32 + 8 * lane) = (f32x4){y[0], y[1], y[2], y[3]}; *(f32x4*)(dst32 + 8 * lane + 4) = (f32x4){y[4], y[5], y[6], y[7]}; }
    if (rope) {
        const int ax = j >> 2, half = (j >> 1) & 1, f0 = 8 * (j & 1);
#pragma unroll
        for (int e = 0; e < 8; ++e) {
            const float c = ropetab[ax * 16 + f0 + e], s = ropetab[32 + ax * 16 + f0 + e];
            const float p = __shfl_xor(y[e], 2);
            y[e] = half == 0 ? (y[e] * c - p * s) : (p * s + y[e] * c);
        }
    }
    if (lane < nact) { u32x4 w; w.x = pk2(y[0], y[1]); w.y = pk2(y[2], y[3]); w.z = pk2(y[4], y[5]); w.w = pk2(y[6], y[7]); *(u32x4*)(dst + 8 * lane) = w; }
}
DI void postproj_even(const Args& a, int li) {
    const int tid = tid_opaque(), lane = tid & 63, wid = tid >> 6;
    const int gw = bid_opaque() * NWAVES + wid, NGW = gridDim.x * NWAVES;
    unsigned char* ws = a.ws;
    const bf16_t* P = (const bf16_t*)(ws + WS_ACT); bf16_t* QA = (bf16_t*)(ws + WS_QA); bf16_t* KA = (bf16_t*)(ws + WS_KA);
    const float* ROPE = (const float*)(ws + WS_ROPE);
    const float* qn = a.in[18] + li * 64; const float* kn = a.in[19] + li * 64;
    u32x4 rq = {0, 0, 0, 0}, rk = {0, 0, 0, 0}, rv = {0, 0, 0, 0};
    if (gw < TT) { const bf16_t* pr = P + (size_t)gw * NPE; rq = *(const u32x4*)(pr + 8 * lane); if (lane < 16) { rk = *(const u32x4*)(pr + 512 + 8 * lane); rv = *(const u32x4*)(pr + 640 + 8 * lane); } }
    for (int row = gw; row < TT; row += NGW) {
        u32x4 nq = {0, 0, 0, 0}, nk = {0, 0, 0, 0}, nv = {0, 0, 0, 0};
        if (row + NGW < TT) { const bf16_t* pn = P + (size_t)(row + NGW) * NPE; nq = *(const u32x4*)(pn + 8 * lane); if (lane < 16) { nk = *(const u32x4*)(pn + 512 + 8 * lane); nv = *(const u32x4*)(pn + 640 + 8 * lane); } }
        const bool smp = row >= TP; const int pos = smp ? ((row - TP) & 4095) : 0;
        const float* rt = ROPE + (size_t)pos * 64;
        float* ko = nullptr;
        if (!smp) { const int b = row >> 8, s = row & 255; ko = a.out + O_KA + ((size_t)(b * 2 + li) * 256 + s) * 128; }
        normrope_block(rq, 64, qn, smp, rt, QA + (size_t)row * 512, nullptr, lane);
        normrope_block(rk, 16, kn, smp, rt, KA + (size_t)row * 128, ko, lane);
        if (!smp && lane < 16) {
            const int b = row >> 8, s = row & 255; float* vo = a.out + O_VA + ((size_t)(b * 2 + li) * 256 + s) * 128 + 8 * lane;
            *(f32x4*)vo = (f32x4){bflo(rv.x), bfhi(rv.x), bflo(rv.y), bfhi(rv.y)}; *(f32x4*)(vo + 4) = (f32x4){bflo(rv.z), bfhi(rv.z), bflo(rv.w), bfhi(rv.w)};
        }
        rq = nq; rk = nk; rv = nv;
    }
    {
        const bf16_t* PQT = (const bf16_t*)(ws + WS_PQT); bf16_t* PQF = (bf16_t*)(ws + WS_PQF);
        const size_t gt = (size_t)bid_opaque() * NTHREADS + tid_opaque(), NGT = (size_t)gridDim.x * NTHREADS;
        const size_t nS = (size_t)4 * 512 * 2 * (HPS / 8), nP = (size_t)16 * 512 * 2 * (HPP / 8);
        for (size_t it = gt; it < nS + nP; it += NGT) {
            const bool smp = it < nS; const size_t i2 = smp ? it : it - nS;
            const int HP = smp ? HPS : HPP, S = smp ? 4096 : 256, nch = HP / 8;
            const size_t rw = i2 / nch; const int c8 = (int)(i2 - rw * nch) * 8, which = (int)(rw & 1);
            const bf16_t* src = PQT + (smp ? (size_t)4194304 : 0) + rw * S;
            bf16_t* dst = PQF + (smp ? PQF_S0 : 0) + rw * HP + c8;
            float v[8];
            if (c8 > S / 2) {
#pragma unroll
                for (int e = 0; e < 8; ++e) v[e] = 0.f;
            } else {
                const u32x4 raw = *(const u32x4*)(src + c8);
                const u32x4 mir = *(const u32x4*)(src + S - c8 - 8);
                const float ym0 = c8 > 0 ? bf2f(src[S - c8]) : 0.f;
                const float x[8] = {bflo(raw.x), bfhi(raw.x), bflo(raw.y), bfhi(raw.y), bflo(raw.z), bfhi(raw.z), bflo(raw.w), bfhi(raw.w)};
                const float y[8] = {ym0, bfhi(mir.w), bflo(mir.w), bfhi(mir.z), bflo(mir.z), bfhi(mir.y), bflo(mir.y), bfhi(mir.x)};
#pragma unroll
                for (int e = 0; e < 8; ++e) {
                    const int s = c8 + e;
                    if (s == 0 || s == S / 2) v[e] = which ? 0.f : x[e];
                    else if (s > S / 2) v[e] = 0.f;
                    else v[e] = which ? x[e] - y[e] : x[e] + y[e];
                }
            }
            u32x4 w; w.x = pk2(v[0], v[1]); w.y = pk2(v[2], v[3]); w.z = pk2(v[4], v[5]); w.w = pk2(v[6], v[7]); *(u32x4*)dst = w;
        }
    }
}
DI void postproj_odd(const Args& a, int li) {
    const int tid = tid_opaque(), lane = tid & 63, wid = tid >> 6;
    const int gw = bid_opaque() * NWAVES + wid, NGW = gridDim.x * NWAVES;
    unsigned char* ws = a.ws;
    const bf16_t* P = (const bf16_t*)(ws + WS_ACT); bf16_t* QC = (bf16_t*)(ws + WS_QC); bf16_t* KC = (bf16_t*)(ws + WS_KC);
    const float* ROPE = (const float*)(ws + WS_ROPE);
    const float* qn = a.in[24] + li * 64; const float* kn = a.in[25] + li * 64;
    u32x4 rq = {0, 0, 0, 0}, rk = {0, 0, 0, 0}, rv = {0, 0, 0, 0};
    if (gw < TT) { const bf16_t* pr = P + (size_t)gw * NPO; rq = *(const u32x4*)(pr + 8 * lane); rk = *(const u32x4*)(pr + 512 + 8 * lane); if (gw < TP) rv = *(const u32x4*)(pr + 1024 + 8 * lane); }
    for (int row = gw; row < TT; row += NGW) {
        u32x4 nq = {0, 0, 0, 0}, nk = {0, 0, 0, 0}, nv = {0, 0, 0, 0};
        if (row + NGW < TT) { const bf16_t* pn = P + (size_t)(row + NGW) * NPO; nq = *(const u32x4*)(pn + 8 * lane); nk = *(const u32x4*)(pn + 512 + 8 * lane); if (row + NGW < TP) nv = *(const u32x4*)(pn + 1024 + 8 * lane); }
        const bool smp = row >= TP; const int pos = smp ? ((row - TP) & 4095) : 0;
        const float* rt = ROPE + (size_t)pos * 64;
        float* ko = nullptr;
        if (!smp) { const int b = row >> 8, s = row & 255; ko = a.out + O_KC + ((size_t)(b * 2 + li) * 256 + s) * 512; }
        normrope_block(rq, 64, qn, smp, rt, QC + (size_t)row * 512, nullptr, lane);
        normrope_block(rk, 64, kn, smp, rt, KC + (size_t)row * 512, ko, lane);
        if (!smp) {
            const int b = row >> 8, s = row & 255; float* vo = a.out + O_VC + ((size_t)(b * 2 + li) * 256 + s) * 512 + 8 * lane;
            *(f32x4*)vo = (f32x4){bflo(rv.x), bfhi(rv.x), bflo(rv.y), bfhi(rv.y)}; *(f32x4*)(vo + 4) = (f32x4){bflo(rv.z), bfhi(rv.z), bflo(rv.w), bfhi(rv.w)};
        }
        rq = nq; rk = nk; rv = nv;
    }
}
#define XB_TMO      128
#define XB_XCNT(j)  (256  + 64 * (j))
#define XB_XSUB(j)  (1280 + 64 * (j))
#define XB_XGEN(j)  (2304 + 64 * (j))
#define XB_TOP      3328
#define XB_TOPGEN   3392
#define XCD_BAR_WORDS 3456
#define XB_SPIN_CAP (1u << 18)

__device__ __forceinline__ unsigned xb_ld(unsigned* p)              { return __hip_atomic_load(p, __ATOMIC_RELAXED, __HIP_MEMORY_SCOPE_AGENT); }
__device__ __forceinline__ unsigned xb_add(unsigned* p, unsigned v) { return __hip_atomic_fetch_add(p, v, __ATOMIC_RELAXED, __HIP_MEMORY_SCOPE_AGENT); }
__device__ __forceinline__ unsigned xb_xcc_id() { return (unsigned)__builtin_amdgcn_s_getreg((3 << 11) | 20) & 0xFu; }
#define XB_SPIN(cond, bar) do { unsigned _sp = 0; while (cond) { __builtin_amdgcn_s_sleep(1); \
    if ((++_sp & 255u) == 0u) { if (xb_ld(&(bar)[XB_TMO])) break; if (_sp > XB_SPIN_CAP) { atomicAdd(&(bar)[XB_TMO], 1u); break; } } } } while (0)

struct XcdBarrier {
    unsigned* bar; unsigned x;
    volatile LAS unsigned* st;
};

__device__ __forceinline__ XcdBarrier xcd_barrier_post(unsigned* bar, volatile LAS unsigned* st) {
    XcdBarrier b; b.bar = bar; b.x = xb_xcc_id(); b.st = st;
    if (threadIdx.x == 0) (void)xb_add(&bar[XB_XCNT(b.x)], 1u);
    return b;
}
__device__ __forceinline__ void xcd_barrier_complete(unsigned* bar, unsigned x, unsigned& nloc, unsigned& nx) {
    const unsigned G = gridDim.x * gridDim.y * gridDim.z;
    unsigned sum, cnt, mine, sp = 0u;
    for (;;) {
        sum = 0u; cnt = 0u; mine = 0u;
#pragma unroll
        for (unsigned j = 0; j < 16; ++j) { const unsigned c = xb_ld(&bar[XB_XCNT(j)]); sum += c; cnt += (c > 0u) ? 1u : 0u; mine = (j == x) ? c : mine; }
        if (sum == G) break;
        __builtin_amdgcn_s_sleep(1);
        if ((++sp & 255u) == 0u) { if (xb_ld(&bar[XB_TMO])) break; if (sp > XB_SPIN_CAP) { atomicAdd(&bar[XB_TMO], 1u); break; } }
    }
    nloc = mine > 0u ? mine : 1u; nx = cnt > 0u ? cnt : 1u;
}

__device__ __forceinline__ void xcd_barrier(const XcdBarrier& b) {
    asm volatile("s_waitcnt vmcnt(0)" ::: "memory");
    __syncthreads();
    if (threadIdx.x == 0) {
        unsigned* bar = sgpr_pin(b.bar); const unsigned bx = sgpr_pin(b.x);
        __builtin_amdgcn_s_waitcnt(0);
        unsigned nloc = b.st[0], nx = b.st[1];
        if (nloc == 0u) { xcd_barrier_complete(bar, bx, nloc, nx); b.st[0] = nloc; b.st[1] = nx; }
        const unsigned old = xb_add(&bar[XB_XSUB(bx)], 1u);
        const unsigned gen = old / nloc;
        if (old + 1u == (gen + 1u) * nloc) {
            __builtin_amdgcn_fence(__ATOMIC_RELEASE, "agent");
            asm volatile("s_waitcnt vmcnt(0)" ::: "memory");
            const unsigned og = xb_add(&bar[XB_TOP], 1u);
            const unsigned tg = og / nx;
            if (og + 1u == (tg + 1u) * nx) xb_add(&bar[XB_TOPGEN], 1u);
            else XB_SPIN(xb_ld(&bar[XB_TOPGEN]) == tg, bar);
            __builtin_amdgcn_fence(__ATOMIC_ACQUIRE, "agent");
            xb_add(&bar[XB_XGEN(bx)], 1u);
            asm volatile("s_waitcnt vmcnt(0)" ::: "memory");
        } else {
            XB_SPIN(xb_ld(&bar[XB_XGEN(bx)]) == gen, bar);
            __builtin_amdgcn_fence(__ATOMIC_ACQUIRE, "agent");
            asm volatile("s_waitcnt vmcnt(0)" ::: "memory");
        }
    }
    __syncthreads();
}

struct FSeg { const bf16_t* K; const bf16_t* V; int pk, pv, nt, pos0, masked; };

template <int DV, bool HASMASK>
DI void flash_tile(const LAS unsigned char* buf, const LAS unsigned char* qlds, f32x16 (&o)[DV / 32], float& m, float& l, int k0, int msk, int qpos, float sc2, int l31, int hi) {
    constexpr int KP = 72, VPD = 40, KBYTES = 64 * KP * 2;
    const LAS bf16_t* KT = (const LAS bf16_t*)buf;
    const LAS unsigned* VT = (const LAS unsigned*)(buf + KBYTES);
    f32x16 s0, s1;
#pragma unroll
    for (int r = 0; r < 16; ++r) { s0[r] = 0.f; s1[r] = 0.f; }
#pragma unroll
    for (int ks = 0; ks < 4; ++ks) {
        const bf16x8 a0 = *(const LAS bf16x8*)(KT + l31 * KP + ks * 16 + hi * 8);
        const bf16x8 a1 = *(const LAS bf16x8*)(KT + (32 + l31) * KP + ks * 16 + hi * 8);
        const bf16x8 qk = *(const LAS bf16x8*)(qlds + ks * 1024);
        s0 = MFMA32(a0, qk, s0); s1 = MFMA32(a1, qk, s1);
    }
    float rm = -3.0e38f;
#pragma unroll
    for (int r = 0; r < 16; ++r) {
        float v0 = s0[r], v1 = s1[r];
        if (HASMASK) { const int kp = k0 + crow(r, hi); int d0 = qpos - kp; d0 = d0 < 0 ? -d0 : d0; int d1 = qpos - kp - 32; d1 = d1 < 0 ? -d1 : d1;
            v0 = (msk != 0 && d0 > 128) ? -1.0e30f : v0; v1 = (msk != 0 && d1 > 128) ? -1.0e30f : v1; s0[r] = v0; s1[r] = v1; }
        rm = __builtin_fmaxf(__builtin_fmaxf(rm, v0), v1);
    }
    rm *= sc2;
    rm = fmaxf(rm, __shfl_xor(rm, 32));
    if (__any(rm > m + 8.f)) {
        const float mn = fmaxf(m, rm); const float alpha = __builtin_amdgcn_exp2f(m - mn); m = mn; l *= alpha;
#pragma unroll
        for (int db = 0; db < DV / 32; ++db) o[db] *= alpha;
    }
    f32x2_t psv = {0.f, 0.f}; const f32x2_t scv = {sc2, sc2}, nmv = {-m, -m};
#pragma unroll
    for (int r = 0; r < 16; ++r) {
        f32x2_t t = {s0[r], s1[r]}; t = t * scv + nmv;
        t.x = __builtin_amdgcn_exp2f(t.x); t.y = __builtin_amdgcn_exp2f(t.y);
        psv += t; s0[r] = t.x; s1[r] = t.y;
    }
    l += psv.x + psv.y;
    bf16x8 bfr[4];
#pragma unroll
    for (int sp = 0; sp < 2; ++sp) {
        u32x4 w0, w1;
        w0.x = pk2(s0[8 * sp], s0[8 * sp + 1]); w0.y = pk2(s0[8 * sp + 2], s0[8 * sp + 3]); w0.z = pk2(s0[8 * sp + 4], s0[8 * sp + 5]); w0.w = pk2(s0[8 * sp + 6], s0[8 * sp + 7]);
        w1.x = pk2(s1[8 * sp], s1[8 * sp + 1]); w1.y = pk2(s1[8 * sp + 2], s1[8 * sp + 3]); w1.z = pk2(s1[8 * sp + 4], s1[8 * sp + 5]); w1.w = pk2(s1[8 * sp + 6], s1[8 * sp + 7]);
        bfr[sp] = __builtin_bit_cast(bf16x8, w0); bfr[2 + sp] = __builtin_bit_cast(bf16x8, w1);
    }
#pragma unroll
    for (int ks = 0; ks < 4; ++ks) {
#pragma unroll
        for (int db = 0; db < DV / 32; ++db) {
            const int d = db * 32 + l31, swz = 2 * ((d >> 3) & 15), dwc = ks * 8 + 2 * hi;
            const u32x2 lo = *(const LAS u32x2*)(VT + d * VPD + (dwc ^ swz));
            const u32x2 hh = *(const LAS u32x2*)(VT + d * VPD + ((dwc + 4) ^ swz));
            u32x4 av; av.x = lo.x; av.y = lo.y; av.z = hh.x; av.w = hh.y;
            o[db] = MFMA32(__builtin_bit_cast(bf16x8, av), bfr[ks], o[db]);
        }
    }
}

template <int DV, bool HASMASK>
DI void flash_run(LAS unsigned char* lds, const bf16x8 (&qf)[4], f32x16 (&o)[DV / 32], float& m, float& l, const FSeg sA, const FSeg sB, int qpos, int qw0, float sc2) {
    const int tid = tid_opaque(), lane = tid & 63, l31 = lane & 31, hi = lane >> 5;
    constexpr int KP = 72, VPD = 40, KBYTES = 64 * KP * 2, VBYTES = DV * VPD * 4, BUFB = KBYTES + VBYTES;
    constexpr int VE = DV / 16, VW = VE / 2;
    const int ntot = sA.nt + sB.nt;
    const int kkey = tid >> 3, kch = (tid & 7) * 8;
    const int vkp = tid >> 4, vd0 = (tid & 15) * VE;
    u32x4 kreg0, kreg1; unsigned va0[VW], vb0[VW], va1[VW], vb1[VW];
#define FL_LOAD(i, kreg, va, vb) do { const bool sec_ = (i) >= sA.nt; const int tl_ = sec_ ? (i) - sA.nt : (i); \
        const bf16_t* Kb_ = sec_ ? sB.K : sA.K; const bf16_t* Vb_ = sec_ ? sB.V : sA.V; const int pk_ = sec_ ? sB.pk : sA.pk, pv_ = sec_ ? sB.pv : sA.pv; \
        kreg = *(const u32x4*)(Kb_ + (size_t)(tl_ * 64 + kkey) * pk_ + kch); \
        const bf16_t* v0_ = Vb_ + (size_t)(tl_ * 64 + 2 * vkp) * pv_ + vd0; \
        if (DV == 128) { const u32x4 t0_ = *(const u32x4*)v0_; const u32x4 t1_ = *(const u32x4*)(v0_ + pv_); \
            va[0] = t0_.x; va[1] = t0_.y; va[VW - 2] = t0_.z; va[VW - 1] = t0_.w; vb[0] = t1_.x; vb[1] = t1_.y; vb[VW - 2] = t1_.z; vb[VW - 1] = t1_.w; } \
        else { const u32x2 t0_ = *(const u32x2*)v0_; const u32x2 t1_ = *(const u32x2*)(v0_ + pv_); va[0] = t0_.x; va[1] = t0_.y; vb[0] = t1_.x; vb[1] = t1_.y; } } while (0)
#define FL_STORE(buf, kreg, va, vb) do { LAS unsigned char* B_ = lds + (buf) * BUFB; \
        *(LAS u32x4*)((LAS bf16_t*)B_ + kkey * KP + kch) = kreg; \
        LAS unsigned* VT_ = (LAS unsigned*)(B_ + KBYTES); \
        _Pragma("unroll") for (int w_ = 0; w_ < VW; ++w_) { \
            const int d0_ = vd0 + 2 * w_, d1_ = d0_ + 1; \
            VT_[d0_ * VPD + (vkp ^ (2 * ((d0_ >> 3) & 15)))] = (va[w_] & 0xffffu) | (vb[w_] << 16); \
            VT_[d1_ * VPD + (vkp ^ (2 * ((d1_ >> 3) & 15)))] = (va[w_] >> 16) | (vb[w_] & 0xffff0000u); } } while (0)
#define FL_TILE(i, buf) do { const bool sec_ = (i) >= sA.nt; const int tl_ = sec_ ? (i) - sA.nt : (i); \
        const int k0_ = (sec_ ? sB.pos0 : sA.pos0) + tl_ * 64; const int msk_ = sec_ ? sB.masked : sA.masked; \
        if (!msk_ || (k0_ + 63 >= qw0 - 128 && k0_ <= qw0 + 31 + 128)) flash_tile<DV, HASMASK>(lds + (buf) * BUFB, qlds, o, m, l, k0_, msk_, qpos, sc2, l31, hi); } while (0)
    LAS unsigned char* qlds = lds + 4 * BUFB + (tid >> 6) * 4096 + lane * 16;
#pragma unroll
    for (int ks = 0; ks < 4; ++ks) *(LAS bf16x8*)(qlds + ks * 1024) = qf[ks];
    if (ntot > 0) { FL_LOAD(0, kreg0, va0, vb0); }
    if (ntot > 1) { FL_LOAD(1, kreg1, va1, vb1); }
    if (ntot > 0) { FL_STORE(0, kreg0, va0, vb0); }
    if (ntot > 1) { FL_STORE(1, kreg1, va1, vb1); }
    __syncthreads();
    for (int i = 0; i < ntot; i += 2) {
        const int pb = (i & 2);
        if (i + 2 < ntot) FL_LOAD(i + 2, kreg0, va0, vb0);
        if (i + 3 < ntot) FL_LOAD(i + 3, kreg1, va1, vb1);
        FL_TILE(i, pb);
        if (i + 1 < ntot) FL_TILE(i + 1, pb + 1);
        if (i + 2 < ntot) FL_STORE(pb ^ 2, kreg0, va0, vb0);
        if (i + 3 < ntot) FL_STORE((pb ^ 2) + 1, kreg1, va1, vb1);
        __syncthreads();
    }
#undef FL_LOAD
#undef FL_STORE
#undef FL_TILE
}

DI void attnA_phase(const Args& a, LAS unsigned char* lds, int li) {
    const int tid = tid_opaque(), lane = tid & 63, l31 = lane & 31, hi = lane >> 5, wid = tid >> 6, G = gridDim.x;
    unsigned char* ws = a.ws;
    const bf16_t* P = (const bf16_t*)(ws + WS_ACT); const bf16_t* QA = (const bf16_t*)(ws + WS_QA); const bf16_t* KA = (const bf16_t*)(ws + WS_KA);
    const bf16_t* CKA = (const bf16_t*)(ws + WS_CKA); const bf16_t* CVA = (const bf16_t*)(ws + WS_CVA);
    bf16_t* MIX = (bf16_t*)(ws + WS_MIX);
    const float sc2 = 0.125f * 1.4426950408889634f;
    const int bidx = bid_opaque();
    const int ubeg = (G == 256) ? (bidx >= 128 ? bidx - 128 : 512 + bidx) : bidx, uend = (G == 256) ? (bidx >= 128 ? 512 : 640) : 640, ustep = (G == 256) ? 128 : G;
    for (int uu = ubeg; uu < uend; uu += ustep) {
        int head, qrow0, qpos0; FSeg sA, sB;
        if (uu < 512) {
            const int b = uu >> 7, rem = uu & 127; head = rem >> 4; const int qb = rem & 15, kvh = head >> 2;
            const int base = TP + b * 4096; qpos0 = qb * 256; qrow0 = base + qpos0;
            int tlo = qpos0 - 128; if (tlo < 0) tlo = 0; tlo >>= 6; int thi = qpos0 + 384; if (thi > 4096) thi = 4096; thi >>= 6;
            sA.K = KA + (size_t)(base + tlo * 64) * 128 + kvh * 64; sA.V = P + (size_t)(base + tlo * 64) * NPE + 640 + kvh * 64; sA.pk = 128; sA.pv = NPE; sA.nt = thi - tlo; sA.pos0 = tlo * 64; sA.masked = 1;
            sB.K = CKA + (size_t)((b * 2 + li) * 256) * 128 + kvh * 64; sB.V = CVA + (size_t)((b * 2 + li) * 256) * 128 + kvh * 64; sB.pk = 128; sB.pv = 128; sB.nt = 4; sB.pos0 = 0; sB.masked = 0;
        } else {
            const int u2 = uu - 512, b = u2 >> 3; head = u2 & 7; const int kvh = head >> 2;
            qrow0 = b * 256; qpos0 = 0;
            sA.K = KA + (size_t)qrow0 * 128 + kvh * 64; sA.V = P + (size_t)qrow0 * NPE + 640 + kvh * 64; sA.pk = 128; sA.pv = NPE; sA.nt = 4; sA.pos0 = 0; sA.masked = 0;
            sB = sA; sB.nt = 0;
        }
        const int qrow = qrow0 + wid * 32 + l31;
        bf16x8 qf[4];
#pragma unroll
        for (int ks = 0; ks < 4; ++ks) qf[ks] = *(const bf16x8*)(QA + (size_t)qrow * 512 + head * 64 + ks * 16 + hi * 8);
        f32x16 o[2];
#pragma unroll
        for (int r = 0; r < 16; ++r) { o[0][r] = 0.f; o[1][r] = 0.f; }
        float m = a.in[20][li * 8 + head] * 1.4426950408889634f, l = hi == 0 ? 1.f : 0.f;
        flash_run<64, true>(lds, qf, o, m, l, sA, sB, qpos0 + wid * 32 + l31, qpos0 + wid * 32, sc2);
        l += __shfl_xor(l, 32);
        const float inv = 1.f / l;
        {
            constexpr int SP = 72; LAS bf16_t* stg = (LAS bf16_t*)(lds + 2 * (9216 + 64 * 40 * 4)) + wid * (32 * SP);
#pragma unroll
            for (int db = 0; db < 2; ++db)
#pragma unroll
                for (int g4 = 0; g4 < 4; ++g4) {
                    u32x2 w; w.x = pk2(o[db][4 * g4] * inv, o[db][4 * g4 + 1] * inv); w.y = pk2(o[db][4 * g4 + 2] * inv, o[db][4 * g4 + 3] * inv);
                    *(LAS u32x2*)(stg + l31 * SP + db * 32 + 8 * g4 + 4 * hi) = w;
                }
            WAVE_LDS_SYNC();
            bf16_t* obase = MIX + (size_t)(qrow0 + wid * 32) * DM + head * 64;
#pragma unroll
            for (int i = 0; i < 4; ++i) { const int row = (lane >> 3) + 8 * i, ch = (lane & 7) * 8; *(u32x4*)(obase + (size_t)row * DM + ch) = *(const LAS u32x4*)(stg + row * SP + ch); }
            WAVE_LDS_SYNC();
        }
    }
}

DI void attnC_phase(const Args& a, LAS unsigned char* lds, int li, int layer) {
    const int tid = tid_opaque(), lane = tid & 63, l31 = lane & 31, hi = lane >> 5, wid = tid >> 6, G = gridDim.x;
    unsigned char* ws = a.ws;
    const bf16_t* P = (const bf16_t*)(ws + WS_ACT); const bf16_t* QC = (const bf16_t*)(ws + WS_QC); const bf16_t* KC = (const bf16_t*)(ws + WS_KC);
    const bf16_t* CKC = (const bf16_t*)(ws + WS_CKC); const bf16_t* CVC = (const bf16_t*)(ws + WS_CVC);
    bf16_t* MIX = (bf16_t*)(ws + WS_MIX);
    const float sc2 = 0.125f * 1.4426950408889634f;
    const float lam_init = 0.8f - 0.6f * expf(-0.3f * (float)sgpr_pin(layer));
    float lam;
    { const float* lv = a.in[26] + li * 256; float d0 = 0.f, d1 = 0.f; for (int e = 0; e < 64; ++e) { d0 += lv[e] * lv[64 + e]; d1 += lv[128 + e] * lv[192 + e]; } lam = expf(d0) - expf(d1) + lam_init; }
    const float* subln = a.in[27] + li * 128;
    for (int uu = bid_opaque(); uu < 320; uu += G) {
        int h, qrow0, krow0, ntl; const bf16_t* ck = nullptr; const bf16_t* cv = nullptr; int ntc = 0;
        if (uu < 256) { const int b = uu >> 6; h = (uu >> 4) & 3; const int qb = uu & 15; krow0 = TP + b * 4096; qrow0 = krow0 + qb * 256; ntl = 64; ck = CKC + (size_t)((b * 2 + li) * 256) * 512 + h * 128; cv = CVC + (size_t)((b * 2 + li) * 256) * 512 + h * 128; ntc = 4; }
        else { const int u2 = uu - 256, b = u2 >> 2; h = u2 & 3; krow0 = b * 256; qrow0 = krow0; ntl = 4; ck = CKC; cv = CVC; ntc = 0; }
        const int qrow = qrow0 + wid * 32 + l31;
        f32x16 o[4];
        u32x4* const o0g = (u32x4*)(ws + WS_O0) + ((size_t)bid_opaque() * NTHREADS + tid) * 8;
#pragma unroll 1
        for (int mp = 0; mp < 2; ++mp) {
            FSeg sA, sB;
            sA.K = KC + (size_t)krow0 * 512 + h * 128 + mp * 64; sA.V = P + (size_t)krow0 * NPO + 1024 + h * 128; sA.pk = 512; sA.pv = NPO; sA.nt = ntl; sA.pos0 = 0; sA.masked = 0;
            sB.K = ck + mp * 64; sB.V = cv; sB.pk = 512; sB.pv = 512; sB.nt = ntc; sB.pos0 = 0; sB.masked = 0;
            bf16x8 qf[4];
#pragma unroll
            for (int ks = 0; ks < 4; ++ks) qf[ks] = *(const bf16x8*)(QC + (size_t)qrow * 512 + h * 128 + mp * 64 + ks * 16 + hi * 8);
#pragma unroll
            for (int db = 0; db < 4; ++db)
#pragma unroll
                for (int r = 0; r < 16; ++r) o[db][r] = 0.f;
            float m = -1.0e30f, l = 0.f;
            flash_run<128, false>(lds, qf, o, m, l, sA, sB, 0, 0, sc2);
            l += __shfl_xor(l, 32);
            const float inv = 1.f / l;
            if (mp == 0) {
#pragma unroll
                for (int db = 0; db < 4; ++db)
#pragma unroll
                    for (int h2 = 0; h2 < 2; ++h2) { u32x4 w; w.x = pk2(o[db][8 * h2] * inv, o[db][8 * h2 + 1] * inv); w.y = pk2(o[db][8 * h2 + 2] * inv, o[db][8 * h2 + 3] * inv); w.z = pk2(o[db][8 * h2 + 4] * inv, o[db][8 * h2 + 5] * inv); w.w = pk2(o[db][8 * h2 + 6] * inv, o[db][8 * h2 + 7] * inv); o0g[db * 2 + h2] = w; }
            } else {
                const float li2 = lam * inv;
#pragma unroll
                for (int db = 0; db < 4; ++db)
#pragma unroll
                    for (int h2 = 0; h2 < 2; ++h2) { const u32x4 w = o0g[db * 2 + h2];
                        o[db][8 * h2 + 0] = bflo(w.x) - o[db][8 * h2 + 0] * li2; o[db][8 * h2 + 1] = bfhi(w.x) - o[db][8 * h2 + 1] * li2; o[db][8 * h2 + 2] = bflo(w.y) - o[db][8 * h2 + 2] * li2; o[db][8 * h2 + 3] = bfhi(w.y) - o[db][8 * h2 + 3] * li2;
                        o[db][8 * h2 + 4] = bflo(w.z) - o[db][8 * h2 + 4] * li2; o[db][8 * h2 + 5] = bfhi(w.z) - o[db][8 * h2 + 5] * li2; o[db][8 * h2 + 6] = bflo(w.w) - o[db][8 * h2 + 6] * li2; o[db][8 * h2 + 7] = bfhi(w.w) - o[db][8 * h2 + 7] * li2; }
            }
        }
        float ss = 0.f;
#pragma unroll
        for (int db = 0; db < 4; ++db)
#pragma unroll
            for (int r = 0; r < 16; ++r) ss += o[db][r] * o[db][r];
        ss += __shfl_xor(ss, 32);
        const float rinv = rsqrtf(ss * (1.f / 128.f) + EPS) * (1.f - lam_init);
        {
            constexpr int SP = 72; LAS bf16_t* stg = (LAS bf16_t*)(lds + 2 * (9216 + 128 * 40 * 4)) + wid * (32 * SP);
            bf16_t* obase = MIX + (size_t)(qrow0 + wid * 32) * DM + h * 128;
#pragma unroll
            for (int hh = 0; hh < 2; ++hh) {
#pragma unroll
                for (int dq = 0; dq < 2; ++dq)
#pragma unroll
                    for (int g4 = 0; g4 < 4; ++g4) {
                        const int db = 2 * hh + dq, d = db * 32 + 8 * g4 + 4 * hi; const f32x4 gs = *(const f32x4*)(subln + d);
                        u32x2 w; w.x = pk2(o[db][4 * g4] * rinv * gs[0], o[db][4 * g4 + 1] * rinv * gs[1]); w.y = pk2(o[db][4 * g4 + 2] * rinv * gs[2], o[db][4 * g4 + 3] * rinv * gs[3]);
                        *(LAS u32x2*)(stg + l31 * SP + dq * 32 + 8 * g4 + 4 * hi) = w;
                    }
                WAVE_LDS_SYNC();
#pragma unroll
                for (int i = 0; i < 4; ++i) { const int row = (lane >> 3) + 8 * i, ch = (lane & 7) * 8; *(u32x4*)(obase + (size_t)row * DM + hh * 64 + ch) = *(const LAS u32x4*)(stg + row * SP + ch); }
                WAVE_LDS_SYNC();
            }
        }
    }
}


constexpr int ML_PT = 136, ML_PD = 68;
constexpr int ML_Q = 0, ML_K = 34816, ML_V = 69632, ML_X = 104448, ML_ARR = 139264;
DI int ml_row0(int u) { return u < 128 ? (u >> 3) * 256 + (u & 1) * 128 : TP + ((u - 128) >> 7) * 4096 + ((u - 128) & 31) * 128; }
DI int ml_head(int u) { return u < 128 ? (u >> 1) & 3 : ((u - 128) >> 5) & 3; }
DI int ml_swz(int row) { return 4 * ((row >> 3) & 7); }
DI void ml_gates(LAS float* AR, const float* gates, const float* bg, int row0, int h, int tid) {
    LAS float* IG = AR; LAS float* LF = AR + 256; LAS float* BC = AR + 512; LAS float* PM = AR + 768;
    if (tid < 256) {
        const int dir = tid >> 7, s = tid & 127;
        const float ig = gates[(size_t)(row0 + s) * 16 + dir * 8 + h] + bg[dir * 8 + h];
        const float fg = gates[(size_t)(row0 + s) * 16 + dir * 8 + 4 + h] + bg[dir * 8 + 4 + h];
        IG[tid] = ig; LF[tid] = fminf(fg, 0.f) - log1pf(__expf(-fabsf(fg)));
    }
    __syncthreads();
    if (tid < 128) {
        const int dir = tid >> 6, lane = tid & 63, k0 = 2 * lane, k1 = k0 + 1;
        const int i0 = dir * 128 + (dir == 0 ? k0 : 127 - k0), i1 = dir * 128 + (dir == 0 ? k1 : 127 - k1);
        const float x0 = LF[i0], x1 = LF[i1], s1 = x0 + x1;
        float incl = s1;
#pragma unroll
        for (int o = 1; o < 64; o <<= 1) { const float t = __shfl_up(incl, o); if (lane >= o) incl += t; }
        const float c0 = incl - s1 + x0, c1 = c0 + x1;
        BC[i0] = c0; BC[i1] = c1;
        const float e0 = IG[i0] - c0, e1 = IG[i1] - c1, m1 = fmaxf(e0, e1);
        float im = m1;
#pragma unroll
        for (int o = 1; o < 64; o <<= 1) { const float t = __shfl_up(im, o); if (lane >= o) im = fmaxf(im, t); }
        float ex = __shfl_up(im, 1); if (lane == 0) ex = -3.0e38f;
        PM[i0] = fmaxf(ex, e0); PM[i1] = fmaxf(ex, m1);
    }
    __syncthreads();
}
DI void ml_load_tile(LAS bf16_t* dst, const bf16_t* src, int pitch, int tid) {
#pragma unroll
    for (int i = 0; i < 4; ++i) { const int grp = tid + 512 * i, s = grp >> 4, c8 = (grp & 15) * 8; *(LAS u32x4*)(dst + s * ML_PT + c8) = *(const u32x4*)(src + (size_t)s * pitch + c8); }
}
DI void ml_store_pair_t(LAS unsigned* dstw, int sp, int c8, const u32x4 r0, const u32x4 r1) {
    const int swz = ml_swz(c8);
    LAS unsigned* p = dstw + c8 * ML_PD + (sp ^ swz);
    p[0 * ML_PD] = (r0.x & 0xffffu) | (r1.x << 16); p[1 * ML_PD] = (r0.x >> 16) | (r1.x & 0xffff0000u);
    p[2 * ML_PD] = (r0.y & 0xffffu) | (r1.y << 16); p[3 * ML_PD] = (r0.y >> 16) | (r1.y & 0xffff0000u);
    p[4 * ML_PD] = (r0.z & 0xffffu) | (r1.z << 16); p[5 * ML_PD] = (r0.z >> 16) | (r1.z & 0xffff0000u);
    p[6 * ML_PD] = (r0.w & 0xffffu) | (r1.w << 16); p[7 * ML_PD] = (r0.w >> 16) | (r1.w & 0xffff0000u);
}
DI void ml_load_tile_t(LAS bf16_t* dst, const bf16_t* src, int pitch, int tid) {
#pragma unroll
    for (int x = 0; x < 2; ++x) {
        const int sp = (tid >> 4) + 32 * x, c8 = (tid & 15) * 8;
        const u32x4 r0 = *(const u32x4*)(src + (size_t)(2 * sp) * pitch + c8), r1 = *(const u32x4*)(src + (size_t)(2 * sp + 1) * pitch + c8);
        ml_store_pair_t((LAS unsigned*)dst, sp, c8, r0, r1);
    }
}
DI bf16x8 ml_frag_t(const LAS bf16_t* tile, int row, int k0) { return *(const LAS bf16x8*)((const LAS unsigned*)tile + row * ML_PD + ((k0 >> 1) ^ ml_swz(row))); }

DI void ml_phase1(const Args& a, LAS unsigned char* lds, int li, int ustart) {
    const int G = gridDim.x;
    unsigned char* ws = a.ws;
    const bf16_t* P = (const bf16_t*)(ws + WS_ACT); const float* GT = (const float*)(ws + WS_GATES);
    float* LB = (float*)(ws + WS_LB); float* NL = (float*)(ws + WS_NL); float* SCAL = (float*)(ws + WS_SCAL);
    LAS bf16_t* KL = (LAS bf16_t*)(lds + ML_K); LAS bf16_t* VT = (LAS bf16_t*)(lds + ML_V); LAS bf16_t* XT = (LAS bf16_t*)(lds + ML_X); LAS float* AR = (LAS float*)(lds + ML_ARR);
    LAS float* IG = AR; LAS float* BC = AR + 512; LAS float* PM = AR + 768; LAS float* WSV = AR + 1024;
    const float* bg = a.in[22] + li * 16;
    for (int u = (bid_opaque() + G - ustart % G) % G; u < NUNIT; u += G) {
        const int tid = tid_opaque(), lane = tid & 63, l31 = lane & 31, hi = lane >> 5, wid = tid >> 6;
        const int ti = wid >> 1, tj0 = (wid & 1) * 2;
        const int row0 = ml_row0(u), h = ml_head(u);
        ml_load_tile(KL, P + (size_t)row0 * NPO + 2048 + h * 128, NPO, tid);
        ml_load_tile_t(VT, P + (size_t)row0 * NPO + 2560 + h * 128, NPO, tid);
        ml_gates(AR, GT, bg, row0, h, tid);
#pragma unroll 1
        for (int dir = 0; dir < 2; ++dir) {
            const float emax = dir == 0 ? PM[127] : PM[128];
            const float bend = dir == 0 ? BC[127] : BC[128];
            if (tid < 128) WSV[tid] = __expf(IG[dir * 128 + tid] - BC[dir * 128 + tid] - emax);
            __syncthreads();
#pragma unroll
            for (int x = 0; x < 2; ++x) {
                const int sp = (tid >> 4) + 32 * x, c8 = (tid & 15) * 8; const float w0 = WSV[2 * sp], w1 = WSV[2 * sp + 1];
                const u32x4 q0 = *(const LAS u32x4*)(KL + (2 * sp) * ML_PT + c8), q1 = *(const LAS u32x4*)(KL + (2 * sp + 1) * ML_PT + c8);
                u32x4 r0, r1;
                r0.x = pk2(bflo(q0.x) * w0, bfhi(q0.x) * w0); r0.y = pk2(bflo(q0.y) * w0, bfhi(q0.y) * w0); r0.z = pk2(bflo(q0.z) * w0, bfhi(q0.z) * w0); r0.w = pk2(bflo(q0.w) * w0, bfhi(q0.w) * w0);
                r1.x = pk2(bflo(q1.x) * w1, bfhi(q1.x) * w1); r1.y = pk2(bflo(q1.y) * w1, bfhi(q1.y) * w1); r1.z = pk2(bflo(q1.z) * w1, bfhi(q1.z) * w1); r1.w = pk2(bflo(q1.w) * w1, bfhi(q1.w) * w1);
                ml_store_pair_t((LAS unsigned*)XT, sp, c8, r0, r1);
            }
            __syncthreads();
            f32x16 acc[2];
#pragma unroll
            for (int r = 0; r < 16; ++r) { acc[0][r] = 0.f; acc[1][r] = 0.f; }
#pragma unroll 2
            for (int ks = 0; ks < 8; ++ks) {
                const bf16x8 av = ml_frag_t(VT, 32 * ti + l31, ks * 16 + 8 * hi);
#pragma unroll
                for (int jj = 0; jj < 2; ++jj) { const bf16x8 bv = ml_frag_t(XT, 32 * (tj0 + jj) + l31, ks * 16 + 8 * hi); acc[jj] = MFMA32(av, bv, acc[jj]); }
            }
            float* Lo = LB + (size_t)(u * 2 + dir) * 16384;
#pragma unroll
            for (int jj = 0; jj < 2; ++jj)
#pragma unroll
                for (int r = 0; r < 16; ++r) Lo[(32 * ti + crow(r, hi)) * 128 + 32 * (tj0 + jj) + l31] = acc[jj][r];
            {
                const int d = tid >> 2, part = tid & 3; float s = 0.f;
#pragma unroll
                for (int q = 0; q < 4; ++q) { const bf16x8 f = ml_frag_t(XT, d, part * 32 + q * 8);
#pragma unroll
                    for (int e = 0; e < 8; ++e) s += bf2f((bf16_t)f[e]); }
                s += __shfl_xor(s, 1); s += __shfl_xor(s, 2);
                if (part == 0) NL[(size_t)(u * 2 + dir) * 128 + d] = s;
            }
            if (tid == 0) { SCAL[u * 2 + dir] = bend; SCAL[2 * NUNIT + u * 2 + dir] = bend + emax; }
            __syncthreads();
        }
    }
}
template <int GS>
DI void ml_scan_group(int k0, int nc, int dir, int ubase, bool isn, int en, int e, const float* __restrict__ SCALr, float* SCALw, const float* __restrict__ NL, const float* __restrict__ LB,
                      float* __restrict__ NPREV, bf16_t* __restrict__ CPREV, f32x4& cur, float& m) {
    int udv[GS]; float bev[GS], mlv[GS]; f32x4 locv[GS];
#pragma unroll
    for (int j = 0; j < GS; ++j) {
        const int k = k0 + j, c = dir == 0 ? k : nc - 1 - k; udv[j] = (ubase + c) * 2 + dir;
        bev[j] = SCALr[udv[j]]; mlv[j] = SCALr[2 * NUNIT + udv[j]];
        locv[j] = isn ? *(const f32x4*)(NL + (size_t)udv[j] * 128 + en) : *(const f32x4*)(LB + (size_t)udv[j] * 16384 + e);
    }
#pragma unroll
    for (int j = 0; j < GS; ++j) {
        const int ud = udv[j];
        if (isn) *(f32x4*)(NPREV + (size_t)ud * 128 + en) = cur;
        else { u32x2 w; w.x = pk2(cur[0], cur[1]); w.y = pk2(cur[2], cur[3]); *(u32x2*)(CPREV + (size_t)ud * 16384 + e) = w; }
        if (e == 0) SCALw[4 * NUNIT + ud] = m;
        const float mn = fmaxf(bev[j] + m, mlv[j]);
        cur = cur * __expf(bev[j] + m - mn) + locv[j] * __expf(mlv[j] - mn); m = mn;
    }
}
DI void ml_phase2(const Args& a, int li) {
    unsigned char* ws = a.ws;
    const float* LB = (const float*)(ws + WS_LB); const float* NL = (const float*)(ws + WS_NL); float* SCAL = (float*)(ws + WS_SCAL);
    bf16_t* CPREV = (bf16_t*)(ws + WS_CPREV); float* NPREV = (float*)(ws + WS_NPREV);
    const size_t gt = (size_t)bid_opaque() * NTHREADS + tid_opaque(), NGT = (size_t)gridDim.x * NTHREADS;
    for (size_t it = gt; it < (size_t)160 * 4128; it += NGT) {
        const int seq = (int)(it / 4128), e = (int)(it - (size_t)seq * 4128) * 4;
        const bool isn = e >= 16384; const int en = e - 16384, vv = e >> 7, d0 = e & 127;
        int b, h, dir, nc, ubase; f32x4 cur = {0.f, 0.f, 0.f, 0.f}; float m; const bool smp = seq >= 128;
        if (!smp) { b = seq >> 3; h = (seq >> 1) & 3; dir = seq & 1; nc = 2; ubase = (b * 4 + h) * 2; m = 0.f; }
        else { const int sq = seq - 128; b = sq >> 3; h = (sq >> 1) & 3; dir = sq & 1; nc = 32; ubase = 128 + (b * 4 + h) * 32;
            const size_t sidx = (size_t)((b * 2 + li) * 2 + dir) * 4 + h;
            if (isn) cur = *(const f32x4*)(a.in[8] + sidx * 128 + en);
            else { const float* s0 = a.in[7] + sidx * 16384 + (size_t)d0 * 128 + vv; cur = (f32x4){s0[0], s0[128], s0[256], s0[384]}; }
            m = a.in[9][sidx]; }
        if (smp) {
#pragma unroll 1
            for (int k0 = 0; k0 < 32; k0 += 8) ml_scan_group<8>(k0, nc, dir, ubase, isn, en, e, SCAL, SCAL, NL, LB, NPREV, CPREV, cur, m);
        } else ml_scan_group<2>(0, nc, dir, ubase, isn, en, e, SCAL, SCAL, NL, LB, NPREV, CPREV, cur, m);
        if (!smp) {
            const size_t sidx = (size_t)((b * 2 + li) * 2 + dir) * 4 + h;
            if (isn) *(f32x4*)(a.out + O_ND + sidx * 128 + en) = cur;
            else { float* o0 = a.out + O_CD + sidx * 16384 + (size_t)d0 * 128 + vv; o0[0] = cur[0]; o0[128] = cur[1]; o0[256] = cur[2]; o0[384] = cur[3]; }
            if (e == 0) a.out[O_MD + sidx] = m;
        }
    }
}
DI void ml_phase3(const Args& a, LAS unsigned char* lds, int li) {
    const int G = gridDim.x;
    unsigned char* ws = a.ws;
    const bf16_t* P = (const bf16_t*)(ws + WS_ACT); const float* GT = (const float*)(ws + WS_GATES);
    const bf16_t* CPREV = (const bf16_t*)(ws + WS_CPREV); const float* NPREV = (const float*)(ws + WS_NPREV); const float* SCAL = (const float*)(ws + WS_SCAL);
    bf16_t* MIX = (bf16_t*)(ws + WS_MIX);
    LAS bf16_t* QL = (LAS bf16_t*)(lds + ML_Q); LAS bf16_t* KL = (LAS bf16_t*)(lds + ML_K); LAS bf16_t* VT = (LAS bf16_t*)(lds + ML_V); LAS bf16_t* XL = (LAS bf16_t*)(lds + ML_X);
    LAS float* AR = (LAS float*)(lds + ML_ARR);
    LAS float* IG = AR; LAS float* BC = AR + 512; LAS float* PM = AR + 768; LAS float* MT = AR + 1024; LAS float* DEN = AR + 1152; LAS float* QN = AR + 1280; LAS float* SS = AR + 1408; LAS float* NP = AR + 1536;
    const float* bg = a.in[22] + li * 16; const float* onorm = a.in[28] + li * 128;
    for (int u = bid_opaque(); u < NUNIT; u += G) {
        const int tid = tid_opaque(), lane = tid & 63, l31 = lane & 31, hi = lane >> 5, wid = tid >> 6;
        const int ti = wid >> 1, tj0 = (wid & 1) * 2;
        const int row0 = ml_row0(u), h = ml_head(u);
        ml_load_tile(QL, P + (size_t)row0 * NPO + 1536 + h * 128, NPO, tid);
        ml_load_tile(KL, P + (size_t)row0 * NPO + 2048 + h * 128, NPO, tid);
        ml_load_tile_t(VT, P + (size_t)row0 * NPO + 2560 + h * 128, NPO, tid);
        ml_gates(AR, GT, bg, row0, h, tid);
        f32x16 S[2], hs[2];
#pragma unroll
        for (int r = 0; r < 16; ++r) { S[0][r] = 0.f; S[1][r] = 0.f; hs[0][r] = 0.f; hs[1][r] = 0.f; }
#pragma unroll 2
        for (int ks = 0; ks < 8; ++ks) {
            const bf16x8 av = *(const LAS bf16x8*)(QL + (32 * ti + l31) * ML_PT + ks * 16 + 8 * hi);
#pragma unroll
            for (int jj = 0; jj < 2; ++jj) { const bf16x8 bv = *(const LAS bf16x8*)(KL + (32 * (tj0 + jj) + l31) * ML_PT + ks * 16 + 8 * hi); S[jj] = MFMA32(av, bv, S[jj]); }
        }
        __syncthreads();
#pragma unroll 1
        for (int dir = 0; dir < 2; ++dir) {
            const int ud = u * 2 + dir; const float mprev = SCAL[4 * NUNIT + ud];
            ml_load_tile(XL, CPREV + (size_t)ud * 16384, 128, tid);
            if (tid < 128) { NP[tid] = NPREV[(size_t)ud * 128 + tid]; MT[tid] = BC[dir * 128 + tid] + fmaxf(mprev, PM[dir * 128 + tid]); }
            __syncthreads();
            const int sg = dir == 0 ? 1 : -1, dts = sg * (32 * ti + 4 * hi - 32 * tj0 - l31);
#pragma unroll
            for (int jj = 0; jj < 2; ++jj) {
                const int s = 32 * (tj0 + jj) + l31; const float es = IG[dir * 128 + s] - BC[dir * 128 + s];
#pragma unroll
                for (int r = 0; r < 16; ++r) {
                    const int t = 32 * ti + crow(r, hi);
                    const bool valid = (dts + sg * (crow(r, 0) - 32 * jj)) >= 0;
                    const float w = valid ? __expf(BC[dir * 128 + t] - MT[t] + es) : 0.f;
                    KL[t * ML_PT + s] = f2bf(S[jj][r] * w);
                }
            }
            __syncthreads();
            {
                const int t = tid >> 2, part = tid & 3; float sd = 0.f, sq = 0.f;
#pragma unroll
                for (int q = 0; q < 4; ++q) {
                    const bf16x8 f = *(const LAS bf16x8*)(KL + t * ML_PT + part * 32 + q * 8);
                    const bf16x8 g = *(const LAS bf16x8*)(QL + t * ML_PT + part * 32 + q * 8);
#pragma unroll
                    for (int e = 0; e < 8; ++e) { sd += bf2f((bf16_t)f[e]); sq += bf2f((bf16_t)g[e]) * NP[part * 32 + q * 8 + e]; }
                }
                sd += __shfl_xor(sd, 1); sd += __shfl_xor(sd, 2); sq += __shfl_xor(sq, 1); sq += __shfl_xor(sq, 2);
                if (part == 0) { DEN[t] = sd; QN[t] = sq; }
            }
            f32x16 acc[2];
#pragma unroll
            for (int r = 0; r < 16; ++r) { acc[0][r] = 0.f; acc[1][r] = 0.f; }
            const float wq = __expf(BC[dir * 128 + 32 * ti + l31] + mprev - MT[32 * ti + l31]);
#pragma unroll 2
            for (int ks = 0; ks < 8; ++ks) {
                const bf16x8 a1 = *(const LAS bf16x8*)(KL + (32 * ti + l31) * ML_PT + ks * 16 + 8 * hi);
                const u32x4 qraw = *(const LAS u32x4*)(QL + (32 * ti + l31) * ML_PT + ks * 16 + 8 * hi);
                u32x4 qs; qs.x = pk2(bflo(qraw.x) * wq, bfhi(qraw.x) * wq); qs.y = pk2(bflo(qraw.y) * wq, bfhi(qraw.y) * wq); qs.z = pk2(bflo(qraw.z) * wq, bfhi(qraw.z) * wq); qs.w = pk2(bflo(qraw.w) * wq, bfhi(qraw.w) * wq);
                const bf16x8 a2 = __builtin_bit_cast(bf16x8, qs);
#pragma unroll
                for (int jj = 0; jj < 2; ++jj) {
                    const bf16x8 bv = ml_frag_t(VT, 32 * (tj0 + jj) + l31, ks * 16 + 8 * hi);
                    acc[jj] = MFMA32(a1, bv, acc[jj]);
                    const bf16x8 bc = *(const LAS bf16x8*)(XL + (32 * (tj0 + jj) + l31) * ML_PT + ks * 16 + 8 * hi);
                    acc[jj] = MFMA32(a2, bc, acc[jj]);
                }
            }
            __syncthreads();
#pragma unroll
            for (int r = 0; r < 16; ++r) {
                const int t = 32 * ti + crow(r, hi);
                const float wi = __expf(BC[dir * 128 + t] + mprev - MT[t]);
                const float den = DEN[t] + wi * QN[t];
                const float dn = fmaxf(fabsf(den), __expf(-MT[t])), rdn = 1.f / dn;
                hs[0][r] += acc[0][r] * rdn; hs[1][r] += acc[1][r] * rdn;
            }
            __syncthreads();
        }
        if (tid < 128) SS[tid] = 0.f;
        __syncthreads();
#pragma unroll
        for (int r = 0; r < 16; ++r) {
            float v = hs[0][r] * hs[0][r] + hs[1][r] * hs[1][r];
            v += __shfl_xor(v, 1); v += __shfl_xor(v, 2); v += __shfl_xor(v, 4); v += __shfl_xor(v, 8); v += __shfl_xor(v, 16);
            if (l31 == 0) atomicAdd((float*)&SS[32 * ti + crow(r, hi)], v);
        }
        __syncthreads();
#pragma unroll
        for (int r = 0; r < 16; ++r) {
            const int t = 32 * ti + crow(r, hi); const float rinv = rsqrtf(SS[t] * (1.f / 128.f) + EPS);
#pragma unroll
            for (int jj = 0; jj < 2; ++jj) { const int v = 32 * (tj0 + jj) + l31; XL[t * ML_PT + v] = f2bf(hs[jj][r] * rinv * onorm[v]); }
        }
        __syncthreads();
#pragma unroll 1
        for (int i = 0; i < 4; ++i) {
            const int grp = tid + 512 * i, t = grp >> 4, c8 = (grp & 15) * 8;
            const u32x4 hv = *(const LAS u32x4*)(XL + t * ML_PT + c8);
            const u32x4 od = *(const u32x4*)(P + (size_t)(row0 + t) * NPO + 3072 + h * 128 + c8);
            u32x4 w;
            w.x = pk2(bflo(hv.x) * sigmoidf_(bflo(od.x)), bfhi(hv.x) * sigmoidf_(bfhi(od.x))); w.y = pk2(bflo(hv.y) * sigmoidf_(bflo(od.y)), bfhi(hv.y) * sigmoidf_(bfhi(od.y)));
            w.z = pk2(bflo(hv.z) * sigmoidf_(bflo(od.z)), bfhi(hv.z) * sigmoidf_(bfhi(od.z))); w.w = pk2(bflo(hv.w) * sigmoidf_(bflo(od.w)), bfhi(hv.w) * sigmoidf_(bfhi(od.w)));
            *(u32x4*)(MIX + (size_t)(row0 + t) * DM + 512 + h * 128 + c8) = w;
        }
        __syncthreads();
    }
}

constexpr size_t WS_CTL = WS_END, CTL_BYTES = 65536, WS_TOTAL = WS_END + 60 * MiB;
constexpr int MISC_OFF = LDS_BYTES - 64;
#ifndef PH_DUP
#define PH_DUP 0
#endif
#define REP(bit) _Pragma("unroll 1") for (int rep_ = 0; rep_ < (((PH_DUP) & (bit)) ? 2 : 1); ++rep_)
#ifndef PH_MASK
#define PH_MASK 0xFFFF
#endif
__global__ void __launch_bounds__(NTHREADS, 2) mega_fwd(Args a) {
    extern __shared__ __attribute__((aligned(16))) unsigned char lds_raw[];
    LAS unsigned char* lds = (LAS unsigned char*)lds_raw;
    cg::grid_group grid = cg::this_grid();
    const int G = gridDim.x;
#define bid bid_opaque()
    unsigned char* ws = a.ws;
    float* X = a.out;
    const float* MOD = (const float*)(ws + WS_MOD);

    if (threadIdx.x < 16) ((LAS unsigned*)(lds + MISC_OFF))[threadIdx.x] = 0u;
    __syncthreads();
    const XcdBarrier xbar = xcd_barrier_post((unsigned*)(ws + WS_CTL), (volatile LAS unsigned*)(lds + MISC_OFF));
    REP(1) if (PH_MASK & 1) prepass(a, lds);
    grid.sync();
#define GRID_BAR() xcd_barrier(xbar)
#pragma unroll 1
    for (int l = 0; l < 4; ++l) {
        const int li = l >> 1; const bool odd = (l & 1) != 0;
        const float* modl = MOD + (size_t)l * 5 * NMODW;
#pragma unroll 1
        for (int sub = 0; sub < 3; ++sub) {
            const bool first = (l == 0 && sub == 0);
            REP(2) if (PH_MASK & 2) norm_phase(a.in[0], a.in[1], first ? nullptr : (const bf16_t*)(ws + WS_XB), (bf16_t*)(ws + WS_HN), a.in[13] + (size_t)(l * 3 + sub) * DM, modl, sub);
            GRID_BAR();
            if (sub != 1) {
                const int jj = sub >> 1;
                const pg8::Gemm g{(const bf16_t*)(ws + WS_HN), (const bf16_t*)(ws + WS_WFI) + (size_t)(l * 2 + jj) * 2 * DFF * DM, TT, 2 * DFF, DM};
                pg8::StaticOrder S; S.init(TT, 2 * DFF, G, bid);
                const EpiSwiglu E{(bf16_t*)(ws + WS_ACT)};
                REP(4) if (PH_MASK & 4) pg8::gemm_phase<EpiSwiglu, pg8::StaticOrder, true, true>(lds, g, S, E);
                GRID_BAR();
            } else {
                {
                    const bf16_t* wi = odd ? (const bf16_t*)(ws + WS_WIO) + (size_t)li * NPO * DM : (const bf16_t*)(ws + WS_WIE) + (size_t)li * 1792 * DM;
                    const pg8::Gemm g{(const bf16_t*)(ws + WS_HN), wi, TT, odd ? NPO : NPE, DM};
                    const EpiStore<0> E{(bf16_t*)(ws + WS_ACT), odd ? NPO : NPE, 1.f, (float*)(ws + WS_GATES), 0, 0};
                    pg8::StaticOrder S; S.init(g.M, g.N, G, bid);
                    REP(8) if (PH_MASK & 8) pg8::gemm_phase<EpiStore<0>, pg8::StaticOrder, true, true>(lds, g, S, E);
                }
                if (!odd) {
                    const pg8::Gemm g{(const bf16_t*)(ws + WS_WIE) + (size_t)li * 1792 * DM + (size_t)768 * DM, (const bf16_t*)(ws + WS_HN), 1024, TT, DM};
                    const EpiStore<1> E{(bf16_t*)(ws + WS_PQT), 0, 1.f, nullptr, 0, 0};
                    pg8::StaticOrder S; S.init(g.M, g.N, G, bid);
                    REP(8192) if (PH_MASK & 8192) pg8::gemm_phase<EpiStore<1>, pg8::StaticOrder, true, true>(lds, g, S, E);
                }
                GRID_BAR();
                if (!odd) {
                    REP(16) if (PH_MASK & 16) postproj_even(a, li);
                    GRID_BAR();
                    REP(32) if (PH_MASK & 32) attnA_phase(a, lds, li);
#pragma unroll 1
                    for (int q = 0; q < 2; ++q) {
                        const pg8::Gemm g{(const bf16_t*)(ws + (q ? WS_DP : WS_DS)), (const bf16_t*)(ws + WS_PQF) + (q ? 0 : PQF_S0), q ? 256 : 4096, q ? 8192 : 2048, q ? 2 * HPP : 2 * HPS};
                        const EpiStore<2> E{(bf16_t*)(ws + WS_MIX), 0, q ? 0.005524271728f : 0.001381067932f, nullptr, q ? 0 : TP, q ? 256 : 4096};
                        const SimpleOrder S{q ? 1 : 16, q ? 32 : 8, G, q ? (bid + G - 128 % G) % G : bid, 0};
                        REP(64) if (PH_MASK & 64) pg8::gemm_phase<EpiStore<2>, SimpleOrder, true, true>(lds, g, S, E);
                    }
                    GRID_BAR();
                } else {
                    REP(128) if (PH_MASK & 128) postproj_odd(a, li);
                    GRID_BAR();
                    REP(256) if (PH_MASK & 256) ml_phase1(a, lds, li, 64);
                    REP(512) if (PH_MASK & 512) attnC_phase(a, lds, li, l);
                    GRID_BAR();
                    REP(1024) if (PH_MASK & 1024) ml_phase2(a, li);
                    GRID_BAR();
                    REP(2048) if (PH_MASK & 2048) ml_phase3(a, lds, li);
                    GRID_BAR();
                }
            }
            {
                const bool ffn = sub != 1;
                const bf16_t* wsrc = ffn ? (const bf16_t*)(ws + WS_WFO) + (size_t)(l * 2 + (sub >> 1)) * DM * DFF : (const bf16_t*)(ws + (odd ? WS_WOO : WS_WOE)) + (size_t)li * DM * DM;
                const pg8::Gemm g{(const bf16_t*)(ws + (ffn ? WS_ACT : WS_MIX)), wsrc, TT, DM, ffn ? DFF : DM};

                pg8::StaticOrder S; S.init(TT, DM, G, bid);
                REP(4096) { const int ls = l * 3 + sub;
                    const EpiResid E{(bf16_t*)(ws + WS_XB), X, a.in[0], a.in[1], modl + (ffn ? (3 * sub + 2) : 5) * DM, rep_ ? 0.f : (ffn ? 0.5f : 1.f), ((first && !rep_) ? 1 : 0) | (ls == 11 ? 2 : 0)};
                    if (PH_MASK & 4096) pg8::gemm_phase<EpiResid, pg8::StaticOrder, true, true>(lds, g, S, E); }
            }
            GRID_BAR();
        }
    }
}

extern "C" void kernel_launch(void* const* d_in, const int* in_sizes, int n_in, void* d_out, int out_size, void* d_ws, size_t ws_size, hipStream_t stream) {
    static int grid = 0;
    if (grid == 0) {
        if (n_in != 29 || out_size != 35684608 || ws_size < WS_TOTAL) { fprintf(stderr, "kernel_launch: unexpected shapes (n_in %d out %d ws %zu need %zu)\n", n_in, out_size, ws_size, (size_t)WS_TOTAL); grid = -1; return; }
        int dev = 0, cus = 0, per_cu = 0;
        hipGetDevice(&dev);
        hipDeviceGetAttribute(&cus, hipDeviceAttributeMultiprocessorCount, dev);
        if (hipFuncSetAttribute((const void*)mega_fwd, hipFuncAttributeMaxDynamicSharedMemorySize, LDS_BYTES) != hipSuccess) { fprintf(stderr, "kernel_launch: hipFuncSetAttribute failed\n"); grid = -1; return; }
        if (hipOccupancyMaxActiveBlocksPerMultiprocessor(&per_cu, (const void*)mega_fwd, NTHREADS, LDS_BYTES) != hipSuccess || per_cu < 1) { fprintf(stderr, "kernel_launch: occupancy query failed (%d)\n", per_cu); (void)hipGetLastError(); per_cu = 1; }
        grid = cus * per_cu;
    }
    if (grid < 0) return;
    if (hipMemsetAsync((char*)d_ws + WS_CTL, 0, CTL_BYTES, stream) != hipSuccess) { fprintf(stderr, "kernel_launch: memset failed\n"); return; }
    Args a{};
    for (int i = 0; i < 29; ++i) a.in[i] = (const float*)d_in[i];
    a.out = (float*)d_out; a.ws = (unsigned char*)d_ws;
    void* args[] = {&a};
    hipError_t e = hipLaunchCooperativeKernel((const void*)mega_fwd, dim3(grid), dim3(NTHREADS), args, LDS_BYTES, stream);
    if (e != hipSuccess) fprintf(stderr, "cooperative launch failed: %s (grid %d)\n", hipGetErrorString(e), grid);
}
```
